# Optimizing an MI355X kernel written in HIP

```python
import math
import jax, jax.numpy as jnp
from jax import lax
import numpy as np

D_MODEL = 1024
BATCH = 4
SEQ = 8192
DEPTH = 2

GRID_W = 64
HEAD_DIM = 64
DA_HEADS = 4
DA_QK = DA_HEADS * HEAD_DIM
DA_WIDTH = DA_HEADS * 2 * HEAD_DIM
NA_HEADS = 8
NA_WIDTH = NA_HEADS * HEAD_DIM
MIX_WIDTH = DA_WIDTH + NA_WIDTH
PROJ_SPLITS = [DA_QK, DA_QK, DA_QK, DA_QK, DA_WIDTH, NA_WIDTH, NA_WIDTH, NA_WIDTH]
PROJ_WIDTH = sum(PROJ_SPLITS)
NA_ROWS = 8
NA_COLS = 16
Q_BLOCK = 128
T5_BUCKETS = 32
T5_MAX_DIST = 128
DA_EPS = 1e-5
N_EXPERTS = 32
TOP_K = 4
D_FF = 1024
SWIGLU_ALPHA = 1.702
SWIGLU_LIMIT = 7.0
LN_EPS = 1e-5
DEEPNORM_ALPHA = (2.0 * DEPTH) ** 0.25
DEEPNORM_BETA = (8.0 * DEPTH) ** -0.25

kernel_name = "hymba_diffattn_natten_moe_deepnorm"


def layer_norm(x, g, b):
    x32 = x.astype(jnp.float32)
    mu = jnp.mean(x32, axis=-1, keepdims=True)
    var = jnp.mean(jnp.square(x32 - mu), axis=-1, keepdims=True)
    y = (x32 - mu) * lax.rsqrt(var + LN_EPS) * g.astype(jnp.float32) + b.astype(jnp.float32)
    return y.astype(x.dtype)


def t5_bucket(rel):
    half = T5_BUCKETS // 2
    max_exact = half // 2
    ret = (rel > 0).astype(jnp.int32) * half
    n = jnp.abs(rel)
    n_f = jnp.maximum(n, 1).astype(jnp.float32)
    large = max_exact + (jnp.log(n_f / max_exact) / math.log(T5_MAX_DIST / max_exact)
                         * (half - max_exact)).astype(jnp.int32)
    large = jnp.minimum(large, half - 1)
    return ret + jnp.where(n < max_exact, n, large)


def diff_attention(q1, q2, k1, k2, v, t5_table, lam, subln_g, lam_init):
    B, S = q1.shape[0], q1.shape[1]
    nb = S // Q_BLOCK
    scale = HEAD_DIM ** -0.5
    kpos = jnp.arange(S, dtype=jnp.int32)

    def blocks(t):
        return jnp.moveaxis(t.reshape(B, nb, Q_BLOCK, *t.shape[2:]), 1, 0)

    def one_block(args):
        q1b, q2b, start = args
        qpos = start + jnp.arange(Q_BLOCK, dtype=jnp.int32)
        rel = kpos[None, :] - qpos[:, None]
        bias = jnp.take(t5_table, t5_bucket(rel), axis=0)
        bias = jnp.transpose(bias, (2, 0, 1))[None].astype(jnp.float32)
        s1 = jnp.einsum('bqhd,bkhd->bhqk', q1b, k1).astype(jnp.float32) * scale + bias
        s2 = jnp.einsum('bqhd,bkhd->bhqk', q2b, k2).astype(jnp.float32) * scale + bias
        a = jax.nn.softmax(s1, axis=-1) - lam * jax.nn.softmax(s2, axis=-1)
        return jnp.einsum('bhqk,bkhe->bqhe', a.astype(v.dtype), v)

    starts = jnp.arange(nb, dtype=jnp.int32) * Q_BLOCK
    o = lax.map(one_block, (blocks(q1), blocks(q2), starts))
    o = jnp.moveaxis(o, 0, 1).reshape(B, S, DA_HEADS, 2 * HEAD_DIM)
    o32 = o.astype(jnp.float32)
    o32 = o32 * lax.rsqrt(jnp.mean(jnp.square(o32), axis=-1, keepdims=True) + DA_EPS)
    o32 = o32 * subln_g.astype(jnp.float32) * (1.0 - lam_init)
    return o32.reshape(B, S, DA_WIDTH).astype(v.dtype)


def neighbourhood_attention(q, k, v, rpb):
    B, S, H, d = q.shape
    rows = S // GRID_W
    kr = min(NA_ROWS, rows)
    scale = d ** -0.5
    qg = q.reshape(B, rows, GRID_W, H, d)
    kg = k.reshape(B, rows, GRID_W, H, d)
    vg = v.reshape(B, rows, GRID_W, H, d)
    col_start = np.clip(np.arange(GRID_W) - NA_COLS // 2, 0, GRID_W - NA_COLS)
    col_idx = (col_start[:, None] + np.arange(NA_COLS)[None, :]).astype(np.int32)
    col_off = (col_idx - np.arange(GRID_W)[:, None] + NA_COLS - 1).astype(np.int32)

    def one_row(r):
        rs = jnp.clip(r - kr // 2, 0, rows - kr)
        q_row = lax.dynamic_index_in_dim(qg, r, axis=1, keepdims=False)
        k_win = lax.dynamic_slice_in_dim(kg, rs, kr, axis=1)[:, :, col_idx]
        v_win = lax.dynamic_slice_in_dim(vg, rs, kr, axis=1)[:, :, col_idx]
        s = jnp.einsum('bqhd,brqchd->bhqrc', q_row, k_win).astype(jnp.float32) * scale
        row_off = rs + jnp.arange(kr, dtype=jnp.int32) - r + NA_ROWS - 1
        bias = rpb[:, row_off[None, :, None], col_off[:, None, :]]
        s = s + bias[None].astype(jnp.float32)
        p = jax.nn.softmax(s.reshape(B, H, GRID_W, kr * NA_COLS), axis=-1).reshape(s.shape)
        return jnp.einsum('bhqrc,brqchd->bqhd', p.astype(v.dtype), v_win)

    o = lax.map(one_row, jnp.arange(rows, dtype=jnp.int32))
    return jnp.moveaxis(o, 0, 1).reshape(B, S, H * d)


def moe(x, router_w, router_b, w_gu, b_gu, w_down, b_down):
    B, S, D = x.shape
    xt = x.reshape(B * S, D)
    logits = (xt @ router_w + router_b).astype(jnp.float32)
    top_v, top_i = lax.top_k(logits, TOP_K)
    gates = jax.nn.softmax(top_v, axis=-1)
    combine = jnp.sum(jax.nn.one_hot(top_i, N_EXPERTS, dtype=jnp.float32) * gates[..., None], axis=1)
    out = jnp.zeros_like(xt)
    for e in range(N_EXPERTS):
        h = xt @ w_gu[e] + b_gu[e]
        gate = jnp.minimum(h[:, :D_FF], SWIGLU_LIMIT)
        up = jnp.clip(h[:, D_FF:], -SWIGLU_LIMIT, SWIGLU_LIMIT)
        glu = gate * jax.nn.sigmoid(gate * SWIGLU_ALPHA)
        y = ((up + 1.0) * glu) @ w_down[e] + b_down[e]
        out = out + combine[:, e:e + 1].astype(y.dtype) * y
    return out.reshape(B, S, D)


def setup_inputs(seed: int = 0) -> dict:
    key = jax.random.key(seed)
    ks = jax.random.split(key, 20)
    f32 = jnp.float32
    nrm = lambda k, shape, s: jax.random.normal(k, shape, f32) * s
    return {
        "x": nrm(ks[0], (BATCH, SEQ, D_MODEL), 1.0),
        "w_in": nrm(ks[1], (DEPTH, D_MODEL, PROJ_WIDTH), D_MODEL ** -0.5),
        "w_out": nrm(ks[2], (DEPTH, MIX_WIDTH, D_MODEL), DEEPNORM_BETA * MIX_WIDTH ** -0.5),
        "lambda_q1": nrm(ks[3], (DEPTH, HEAD_DIM), 0.1),
        "lambda_k1": nrm(ks[4], (DEPTH, HEAD_DIM), 0.1),
        "lambda_q2": nrm(ks[5], (DEPTH, HEAD_DIM), 0.1),
        "lambda_k2": nrm(ks[6], (DEPTH, HEAD_DIM), 0.1),
        "subln_g": 1.0 + nrm(ks[7], (DEPTH, 2 * HEAD_DIM), 0.02),
        "t5_table": nrm(ks[8], (T5_BUCKETS, DA_HEADS), 0.1),
        "na_rpb": nrm(ks[9], (DEPTH, NA_HEADS, 2 * NA_ROWS - 1, 2 * NA_COLS - 1), 0.1),
        "ln1_g": 1.0 + nrm(ks[10], (DEPTH, D_MODEL), 0.02),
        "ln1_b": nrm(ks[11], (DEPTH, D_MODEL), 0.02),
        "router_w": nrm(ks[12], (DEPTH, D_MODEL, N_EXPERTS), D_MODEL ** -0.5),
        "router_b": nrm(ks[13], (DEPTH, N_EXPERTS), 0.01),
        "w_gate_up": nrm(ks[14], (DEPTH, N_EXPERTS, D_MODEL, 2 * D_FF), D_MODEL ** -0.5),
        "b_gate_up": nrm(ks[15], (DEPTH, N_EXPERTS, 2 * D_FF), 0.01),
        "w_down": nrm(ks[16], (DEPTH, N_EXPERTS, D_FF, D_MODEL), DEEPNORM_BETA * D_FF ** -0.5),
        "b_down": nrm(ks[17], (DEPTH, N_EXPERTS, D_MODEL), 0.01),
        "ln2_g": 1.0 + nrm(ks[18], (DEPTH, D_MODEL), 0.02),
        "ln2_b": nrm(ks[19], (DEPTH, D_MODEL), 0.02),
    }


def reference(x, w_in, w_out, lambda_q1, lambda_k1, lambda_q2, lambda_k2, subln_g, t5_table,
              na_rpb, ln1_g, ln1_b, router_w, router_b, w_gate_up, b_gate_up, w_down, b_down,
              ln2_g, ln2_b):
    B, S, D = x.shape
    split_at = list(np.cumsum(PROJ_SPLITS)[:-1])
    for l in range(DEPTH):
        h = x @ w_in[l]
        q1, q2, k1, k2, va, qn, kn, vn = jnp.split(h, split_at, axis=-1)
        hd = lambda t, nh: t.reshape(B, S, nh, t.shape[-1] // nh)
        lam_init = 0.8 - 0.6 * math.exp(-0.3 * l)
        lam = (jnp.exp(jnp.sum(lambda_q1[l].astype(jnp.float32) * lambda_k1[l].astype(jnp.float32)))
               - jnp.exp(jnp.sum(lambda_q2[l].astype(jnp.float32) * lambda_k2[l].astype(jnp.float32)))
               + lam_init)
        o_da = diff_attention(hd(q1, DA_HEADS), hd(q2, DA_HEADS), hd(k1, DA_HEADS), hd(k2, DA_HEADS),
                              hd(va, DA_HEADS), t5_table, lam, subln_g[l], lam_init)
        o_na = neighbourhood_attention(hd(qn, NA_HEADS), hd(kn, NA_HEADS), hd(vn, NA_HEADS), na_rpb[l])
        mix = jnp.concatenate([o_da, o_na], axis=-1) @ w_out[l]
        x = layer_norm(DEEPNORM_ALPHA * x + mix, ln1_g[l], ln1_b[l])
        ffn = moe(x, router_w[l], router_b[l], w_gate_up[l], b_gate_up[l], w_down[l], b_down[l])
        x = layer_norm(DEEPNORM_ALPHA * x + ffn, ln2_g[l], ln2_b[l])
    return x
```

```cpp
#include <hip/hip_runtime.h>
#include <cstdio>
#include <cstdint>

__device__ __forceinline__ int tid_opaque() { int t = (int)threadIdx.x; asm volatile("" : "+v"(t)); return t; }
__device__ __forceinline__ int sgpr_opaque(int v) { asm volatile("" : "+s"(v)); return v; }
namespace pg8 {
#define PG8_LAS __attribute__((address_space(3)))
typedef unsigned short bf16_t;
typedef short bf16x8 __attribute__((ext_vector_type(8)));
typedef float f32x4 __attribute__((ext_vector_type(4)));
typedef unsigned u32x4 __attribute__((ext_vector_type(4)));
constexpr int BM = 256, BK = 64, HALF = 128, HTB = HALF * BK * 2  , STAGE_BYTES = 8 * HTB, NXCD = 8, WGM = 8;

__host__ __device__ __forceinline__ int lds_byte(int r, int c) { const int st = (r >> 4) * 2 + (c >> 5), rr = r & 15, cc = c & 31, ob = rr * 64 + cc * 2; return st * 1024 + (ob ^ (((ob >> 9) & 1) << 5)); }
__host__ __device__ __forceinline__ void stage_rc(int b, int& R, int& C) { const int st = b / 1024, sb = b % 1024, swz = sb ^ (((sb >> 9) & 1) << 5); R = (st >> 1) * 16 + swz / 64; C = (st & 1) * 32 + (swz % 64) / 2; }
__host__ __device__ __forceinline__ int perm32(int rho) { const int n = rho >> 4, i = rho & 15; return 8 * (i >> 2) + 4 * n + (i & 3); }

struct Unit { int pm, pn, e; size_t boff; };
struct Gemm { const bf16_t* A; const bf16_t* Bt; int M, N, K; };

struct TileOrder {
    int nM, nN, nwg, G, c; const PG8_LAS unsigned char* te; size_t gstride;
    __device__ void init(int nM_, int nN_, int G_, int c_, const PG8_LAS unsigned char* te_, size_t gstride_) { nM = nM_; nN = nN_; nwg = nM * nN; G = G_; c = c_; te = te_; gstride = gstride_; }
    __device__ __forceinline__ bool next(int i, Unit& u) const {
        const long L = (long)i * G + c; if (L >= nwg) return false;
        int wgid = (int)L; { const int q = nwg / NXCD, r = nwg % NXCD, xcd = wgid % NXCD, off = wgid / NXCD; wgid = (xcd < r ? xcd * (q + 1) : r * (q + 1) + (xcd - r) * q) + off; }
        const int nig = WGM * nN, gid = wgid / nig, fm = gid * WGM, gsz = (nM - fm) < WGM ? (nM - fm) : WGM;
        u.pm = fm + ((wgid % nig) % gsz); u.pn = (wgid % nig) / gsz;
        int e = 0; if (te) e = (int)te[u.pm];
        u.e = __builtin_amdgcn_readfirstlane(e); u.boff = (size_t)u.e * gstride; return true;
    }
    __device__ __forceinline__ void a_ready(const Unit&) const {}
    __device__ __forceinline__ void done(const Unit&) const {}
};

typedef float f32x2 __attribute__((ext_vector_type(2))); typedef __bf16 bf16x2v __attribute__((ext_vector_type(2)));
__device__ __forceinline__ unsigned cvt_pk_bf16(float lo, float hi) { f32x2 v = {lo, hi}; bf16x2v b = __builtin_convertvector(v, bf16x2v); return __builtin_bit_cast(unsigned, b); }

struct EpiInProj {
    static constexpr bool PERM = true, AFTER_DRAIN = false;
    bf16_t* O; int ldc; float qscale;
    __device__ __forceinline__ void operator()(const f32x4 (&acc)[2][2][4][2], const Unit& u, int wr, int wc, int fr, int fq) const {
        const int row0 = u.pm * BM + wr * 64 + fr; const int colt = u.pn * BM;
        const float sc = (colt < 512 || (colt >= 1536 && colt < 2048)) ? qscale : 1.f;
        const int col0 = colt + wc * 32 + 8 * fq;
#pragma unroll
        for (int ai = 0; ai < 2; ++ai)
#pragma unroll
            for (int m = 0; m < 4; ++m) { bf16_t* rowp = O + (size_t)(row0 + ai * HALF + m * 16) * ldc + col0;
#pragma unroll
                for (int bj = 0; bj < 2; ++bj) { f32x4 v0 = acc[ai][bj][m][0] * sc, v1 = acc[ai][bj][m][1] * sc;
                    u32x4 w; w.x = cvt_pk_bf16(v0[0], v0[1]); w.y = cvt_pk_bf16(v0[2], v0[3]); w.z = cvt_pk_bf16(v1[0], v1[1]); w.w = cvt_pk_bf16(v1[2], v1[3]);
                    *(u32x4*)(rowp + bj * HALF) = w; } }
    }
};
struct EpiResF32 {
    static constexpr bool PERM = false, AFTER_DRAIN = false;
    float* C; const float* R; int ldc; float alpha;
    __device__ __forceinline__ void operator()(const f32x4 (&acc)[2][2][4][2], const Unit& u, int wr, int wc, int fr, int fq) const {
        const int row0 = u.pm * BM + wr * 64 + fr, col0 = u.pn * BM + wc * 32 + 4 * fq;
#pragma unroll
        for (int ai = 0; ai < 2; ++ai)
#pragma unroll
            for (int m = 0; m < 4; ++m) { const size_t ro = (size_t)(row0 + ai * HALF + m * 16) * ldc + col0;
#pragma unroll
                for (int bj = 0; bj < 2; ++bj)
#pragma unroll
                    for (int n = 0; n < 2; ++n) { const f32x4 rv = *(const f32x4*)(R + ro + bj * HALF + n * 16); *(f32x4*)(C + ro + bj * HALF + n * 16) = acc[ai][bj][m][n] + rv * alpha; } }
    }
};
struct EpiSwiGLU {
    static constexpr bool PERM = true, AFTER_DRAIN = false;
    bf16_t* H; const float* bias;
    __device__ __forceinline__ void operator()(const f32x4 (&acc)[2][2][4][2], const Unit& u, int wr, int wc, int fr, int fq) const {
        const int row0 = u.pm * BM + wr * 64 + fr; const int c0 = u.pn * HALF + wc * 32 + 8 * fq;
        const float* bg = bias + (size_t)u.e * 2048 + c0; const float* bu = bg + 1024;
        f32x4 g0 = *(const f32x4*)bg, g1 = *(const f32x4*)(bg + 4), u0 = *(const f32x4*)bu, u1 = *(const f32x4*)(bu + 4);
#pragma unroll
        for (int ai = 0; ai < 2; ++ai)
#pragma unroll
            for (int m = 0; m < 4; ++m) { bf16_t* rowp = H + (size_t)(row0 + ai * HALF + m * 16) * 1024 + c0;
                float hv[8];
#pragma unroll
                for (int n = 0; n < 2; ++n) { const f32x4 ga = acc[ai][0][m][n] + (n ? g1 : g0), ua = acc[ai][1][m][n] + (n ? u1 : u0);
#pragma unroll
                    for (int i = 0; i < 4; ++i) { const float g = fminf(ga[i], 7.0f), up = fminf(fmaxf(ua[i], -7.0f), 7.0f);
                        const float sg = __builtin_amdgcn_rcpf(1.0f + __builtin_amdgcn_exp2f(g * (-1.702f * 1.4426950408889634f)));
                        hv[4 * n + i] = (up + 1.0f) * (g * sg); } }
                u32x4 w; w.x = cvt_pk_bf16(hv[0], hv[1]); w.y = cvt_pk_bf16(hv[2], hv[3]); w.z = cvt_pk_bf16(hv[4], hv[5]); w.w = cvt_pk_bf16(hv[6], hv[7]);
                *(u32x4*)rowp = w; }
    }
};
struct EpiDown {
    static constexpr bool PERM = true, AFTER_DRAIN = false;
    bf16_t* Y; const float* bias;
    __device__ __forceinline__ void operator()(const f32x4 (&acc)[2][2][4][2], const Unit& u, int wr, int wc, int fr, int fq) const {
        const int row0 = u.pm * BM + wr * 64 + fr; const int col0 = u.pn * BM + wc * 32 + 8 * fq;
        const float* bp = bias + (size_t)u.e * 1024 + col0;
        f32x4 bv[2][2];
#pragma unroll
        for (int bj = 0; bj < 2; ++bj)
#pragma unroll
            for (int n = 0; n < 2; ++n) bv[bj][n] = *(const f32x4*)(bp + bj * HALF + 4 * n);
#pragma unroll
        for (int ai = 0; ai < 2; ++ai)
#pragma unroll
            for (int m = 0; m < 4; ++m) { bf16_t* rowp = Y + (size_t)(row0 + ai * HALF + m * 16) * 1024 + col0;
#pragma unroll
                for (int bj = 0; bj < 2; ++bj) { const f32x4 v0 = acc[ai][bj][m][0] + bv[bj][0], v1 = acc[ai][bj][m][1] + bv[bj][1];
                    u32x4 w; w.x = cvt_pk_bf16(v0[0], v0[1]); w.y = cvt_pk_bf16(v0[2], v0[3]); w.z = cvt_pk_bf16(v1[0], v1[1]); w.w = cvt_pk_bf16(v1[2], v1[3]);
                    *(u32x4*)(rowp + bj * HALF) = w; } }
    }
};

template <class Epi, class Sched, bool ALIGN_EPI = false, bool SP2 = false>
__device__ __forceinline__ void gemm_phase(PG8_LAS unsigned char* lds, const Gemm g, const Sched& S, const Epi& E) {
    const int tid = tid_opaque(), wid = __builtin_amdgcn_readfirstlane(tid >> 6), lane = tid & 63, wr = wid >> 2, wc = wid & 3, fr = lane & 15, fq = lane >> 4;
    const int K = g.K, nt = K / BK;
    unsigned voffA[2], voffB[2];
#pragma unroll
    for (int i = 0; i < 2; ++i) { int R, C; stage_rc(tid * 16 + i * 8192, R, C); const int Rb = Epi::PERM ? ((R & ~31) + perm32(R & 31)) : R;
        voffA[i] = (unsigned)(R * K + C) * 2u; voffB[i] = (unsigned)(Rb * K + C) * 2u; }
    const size_t kstep = (size_t)(BK * 2);
    const size_t hstep = (size_t)HALF * K * 2;
    const size_t tstep = 2 * hstep;
    const unsigned ldsw = (unsigned)wid * 1024u;
    const int aoff = lds_byte(wr * 64 + fr, fq * 8), boff = lds_byte(wc * 32 + fr, fq * 8);
#define PG8_SA(b, h) (((b) * 2 + (h)) * HTB)
#define PG8_SB(b, h) ((4 + (b) * 2 + (h)) * HTB)
#define PG8_STAGE(bufoff, gbase, voff) do { _Pragma("unroll") for (int _i = 0; _i < 2; ++_i) \
        __builtin_amdgcn_global_load_lds((const unsigned*)((const char*)(gbase) + (voff)[_i]), (PG8_LAS unsigned*)(lds + (bufoff) + ldsw + _i * 8192), 16, 0, 0); } while (0)
#define PG8_LDA(dst, b, h) do { _Pragma("unroll") for (int m = 0; m < 4; ++m) _Pragma("unroll") for (int k = 0; k < 2; ++k) dst[m][k] = *(const PG8_LAS bf16x8*)(lds + PG8_SA(b, h) + aoff + m * 2048 + k * 1024); } while (0)
#define PG8_LDB(dst, b, h) do { _Pragma("unroll") for (int n = 0; n < 2; ++n) _Pragma("unroll") for (int k = 0; k < 2; ++k) dst[n][k] = *(const PG8_LAS bf16x8*)(lds + PG8_SB(b, h) + boff + n * 2048 + k * 1024); } while (0)
#define PG8_MMA(ai, bj, At, Bt) do { __builtin_amdgcn_s_setprio(1); _Pragma("unroll") for (int m = 0; m < 4; ++m) _Pragma("unroll") for (int n = 0; n < 2; ++n) _Pragma("unroll") for (int k = 0; k < 2; ++k) \
        acc[ai][bj][m][n] = __builtin_amdgcn_mfma_f32_16x16x32_bf16(Bt[n][k], At[m][k], acc[ai][bj][m][n], 0, 0, 0); __builtin_amdgcn_s_setprio(0); } while (0)
#define PG8_WAIT_V(n) asm volatile("s_waitcnt vmcnt(" #n ")" ::: "memory")
#define PG8_WAIT_L(n) asm volatile("s_waitcnt lgkmcnt(" #n ")" ::: "memory")
#define PG8_BAR __builtin_amdgcn_s_barrier()
#define PG8_SCHED __builtin_amdgcn_sched_barrier(0)
    Unit cur, nxt; int ui = 0;
    if (!S.next(0, cur)) return;
    f32x4 acc[2][2][4][2];
#pragma unroll
    for (int a = 0; a < 2; ++a)
#pragma unroll
        for (int b = 0; b < 2; ++b)
#pragma unroll
            for (int m = 0; m < 4; ++m)
#pragma unroll
                for (int n = 0; n < 2; ++n) acc[a][b][m][n] = (f32x4){0.f, 0.f, 0.f, 0.f};
    bf16x8 At[4][2], B0[2][2], B1[2][2];
    const char* cA = (const char*)g.A + (size_t)cur.pm * tstep; const char* cB = (const char*)g.Bt + cur.boff + (size_t)cur.pn * tstep;
    S.a_ready(cur);
    if constexpr (SP2) {
        PG8_STAGE(PG8_SB(0, 0), cB, voffB); PG8_STAGE(PG8_SB(0, 1), cB + hstep, voffB); PG8_STAGE(PG8_SA(0, 0), cA, voffA); PG8_STAGE(PG8_SA(0, 1), cA + hstep, voffA);
        if (wr == 1) PG8_BAR;
        PG8_WAIT_V(2); PG8_BAR;
        PG8_STAGE(PG8_SB(1, 0), cB + kstep, voffB); PG8_STAGE(PG8_SA(1, 0), cA + kstep, voffA); PG8_STAGE(PG8_SB(1, 1), cB + hstep + kstep, voffB);
        PG8_WAIT_V(6); PG8_BAR;
    } else {
        PG8_STAGE(PG8_SB(0, 0), cB, voffB); PG8_STAGE(PG8_SA(0, 0), cA, voffA); PG8_STAGE(PG8_SB(0, 1), cB + hstep, voffB); PG8_STAGE(PG8_SA(0, 1), cA + hstep, voffA);
        if (wr == 1) PG8_BAR;
        PG8_WAIT_V(4); PG8_BAR;
        PG8_STAGE(PG8_SB(1, 0), cB + kstep, voffB); PG8_STAGE(PG8_SA(1, 0), cA + kstep, voffA); PG8_STAGE(PG8_SB(1, 1), cB + hstep + kstep, voffB);
        PG8_WAIT_V(6); PG8_BAR;
    }
    for (;;) {
        const bool has_next = S.next(ui + 1, nxt);
        const char* nA = has_next ? (const char*)g.A + (size_t)nxt.pm * tstep : cA; const char* nB = has_next ? (const char*)g.Bt + nxt.boff + (size_t)nxt.pn * tstep : cB;
        for (int t = 0; t < nt; t += 2) {
            const bool last = (t == nt - 2);
            const char* a1 = cA + (size_t)(t + 1) * kstep;
            const char* a2 = last ? nA : cA + (size_t)(t + 2) * kstep; const char* b2 = last ? nB : cB + (size_t)(t + 2) * kstep;
            const char* a3 = a2 + kstep; const char* b3 = b2 + kstep;
            if (last && has_next) S.a_ready(nxt);
            if constexpr (SP2) {
            PG8_LDB(B0, 0, 0); PG8_LDB(B1, 0, 1); PG8_SCHED; PG8_LDA(At, 0, 0); PG8_STAGE(PG8_SA(1, 1), a1 + hstep, voffA);
            PG8_WAIT_V(8); PG8_WAIT_L(0); PG8_BAR; PG8_MMA(0, 0, At, B0); PG8_MMA(0, 1, At, B1); PG8_BAR; PG8_SCHED;
            PG8_LDA(At, 0, 1); PG8_STAGE(PG8_SB(0, 0), b2, voffB); PG8_STAGE(PG8_SB(0, 1), b2 + hstep, voffB); PG8_STAGE(PG8_SA(0, 0), a2, voffA);
            PG8_WAIT_V(8); PG8_WAIT_L(0); PG8_BAR; PG8_MMA(1, 0, At, B0); PG8_MMA(1, 1, At, B1); PG8_BAR; PG8_SCHED;
            PG8_LDB(B0, 1, 0); PG8_LDB(B1, 1, 1); PG8_SCHED; PG8_LDA(At, 1, 0); PG8_STAGE(PG8_SA(0, 1), a2 + hstep, voffA);
            PG8_WAIT_V(8); PG8_WAIT_L(0); PG8_BAR; PG8_MMA(0, 0, At, B0); PG8_MMA(0, 1, At, B1); PG8_BAR; PG8_SCHED;
            PG8_LDA(At, 1, 1); PG8_STAGE(PG8_SB(1, 0), b3, voffB); PG8_STAGE(PG8_SB(1, 1), b3 + hstep, voffB); PG8_STAGE(PG8_SA(1, 0), a3, voffA);
            PG8_WAIT_V(8); PG8_WAIT_L(0); PG8_BAR; PG8_MMA(1, 0, At, B0); PG8_MMA(1, 1, At, B1); PG8_BAR; PG8_SCHED;
            } else {
            PG8_LDB(B0, 0, 0); PG8_SCHED; PG8_LDA(At, 0, 0); PG8_STAGE(PG8_SA(1, 1), a1 + hstep, voffA);
            PG8_WAIT_L(8); PG8_BAR; PG8_WAIT_L(0); PG8_MMA(0, 0, At, B0); PG8_BAR; PG8_SCHED;
            PG8_LDB(B1, 0, 1); PG8_STAGE(PG8_SB(0, 0), b2, voffB);
            PG8_BAR; PG8_WAIT_L(0); PG8_MMA(0, 1, At, B1); PG8_BAR;
            PG8_LDA(At, 0, 1); PG8_STAGE(PG8_SA(0, 0), a2, voffA);
            PG8_BAR; PG8_WAIT_L(0); PG8_MMA(1, 0, At, B0); PG8_BAR; PG8_SCHED;
            PG8_STAGE(PG8_SB(0, 1), b2 + hstep, voffB);
            PG8_WAIT_V(6); PG8_BAR; PG8_MMA(1, 1, At, B1); PG8_BAR;
            PG8_LDB(B0, 1, 0); PG8_SCHED; PG8_LDA(At, 1, 0); PG8_STAGE(PG8_SA(0, 1), a2 + hstep, voffA);
            PG8_WAIT_L(8); PG8_BAR; PG8_WAIT_L(0); PG8_MMA(0, 0, At, B0); PG8_BAR; PG8_SCHED;
            PG8_LDB(B1, 1, 1); PG8_STAGE(PG8_SB(1, 0), b3, voffB);
            PG8_BAR; PG8_WAIT_L(0); PG8_MMA(0, 1, At, B1); PG8_BAR;
            PG8_LDA(At, 1, 1); PG8_STAGE(PG8_SA(1, 0), a3, voffA);
            PG8_BAR; PG8_WAIT_L(0); PG8_MMA(1, 0, At, B0); PG8_BAR; PG8_SCHED;
            PG8_STAGE(PG8_SB(1, 1), b3 + hstep, voffB);
            PG8_WAIT_V(6); PG8_BAR; PG8_MMA(1, 1, At, B1); PG8_BAR;
            }
        }
        if constexpr (ALIGN_EPI) { if (wr == 0) PG8_BAR; }
        if constexpr (!Epi::AFTER_DRAIN) { E(acc, cur, wr, wc, fr, fq); S.done(cur); }
        if (!has_next) break;
#pragma unroll
        for (int a = 0; a < 2; ++a)
#pragma unroll
            for (int b = 0; b < 2; ++b)
#pragma unroll
                for (int m = 0; m < 4; ++m)
#pragma unroll
                    for (int n = 0; n < 2; ++n) acc[a][b][m][n] = (f32x4){0.f, 0.f, 0.f, 0.f};
        cur = nxt; cA = nA; cB = nB; ++ui;
        if constexpr (ALIGN_EPI) { if (wr == 1) PG8_BAR; }
    }
    PG8_WAIT_V(0);
    if constexpr (!ALIGN_EPI) { if (wr == 0) PG8_BAR; }
    PG8_BAR;
    if constexpr (Epi::AFTER_DRAIN) { E.fused(acc, cur, wr, wc, fr, fq, lds, wid, lane); S.done(cur); }
#undef PG8_SA
#undef PG8_SB
#undef PG8_STAGE
#undef PG8_LDA
#undef PG8_LDB
#undef PG8_MMA
#undef PG8_WAIT_V
#undef PG8_WAIT_L
#undef PG8_BAR
#undef PG8_SCHED
}
}

#ifndef PG8_SP2
#define PG8_SP2 true
#endif
#ifndef PG8_ALIGN
#define PG8_ALIGN true
#endif
#ifndef MK_N_LAUNCHES
#define MK_N_LAUNCHES 1
#endif

constexpr int NWAVES = 8;
constexpr int NB = 4, SEQ = 8192, T = NB * SEQ, D = 1024, PW = 3072, NE = 32, TOPK = 4, DFF = 1024, DEPTH = 2;
constexpr int GRIDW = 64, GROWS = SEQ / GRIDW;
constexpr int MPAD_MAX = T * TOPK + NE * 256;
constexpr float LN_EPS = 1e-5f, DA_EPS = 1e-5f;
constexpr float LOG2E = 1.4426950408889634f;
constexpr float C2 = 0.125f * LOG2E;
constexpr float DN_ALPHA = 1.4142135623730951f;
constexpr int N_PHASES = 1 + 8 * DEPTH;

constexpr size_t MiB = 1u << 20;
constexpr size_t WS_CTL = 0, CTL_ZERO_BYTES = 1 * MiB;
constexpr size_t WS_WIN = 2 * MiB, WS_WOUT = 14 * MiB, WS_WGU = 18 * MiB, WS_WDN = 274 * MiB;
constexpr size_t WS_XB = 402 * MiB;
constexpr size_t WS_RA = 466 * MiB;
constexpr size_t WS_HB = WS_RA, WS_OB = WS_RA + 192 * MiB, WS_PRE = WS_RA + 256 * MiB, WS_XS = WS_RA, WS_Y = WS_RA;
constexpr size_t WS_X1F = 850 * MiB, WS_X1B = 978 * MiB, WS_HID = 1042 * MiB, WS_X2F = 1314 * MiB;
constexpr size_t WS_TKE = 1442 * MiB, WS_TKG = WS_TKE + 512 * 1024, WS_SLOT = 1443 * MiB, WS_TOKL = 1444 * MiB, WS_END = 1448 * MiB;
static_assert((size_t)MPAD_MAX * 1024 * 2 <= 272 * MiB, "XS/HID/Y size");
constexpr int CW_BAR = 4096;
constexpr int CW_CNT = 65536;

constexpr int RING_OFF = 0, RING_BYTES = 131072;
constexpr int LDSCTL_OFF = RING_BYTES;
constexpr int MISC_OFF = LDSCTL_OFF;
constexpr int POFF_OFF = LDSCTL_OFF + 256;
constexpr int ECNT_OFF = LDSCTL_OFF + 512;
constexpr int TILEE_OFF = LDSCTL_OFF + 768;
constexpr int BTAB_OFF = LDSCTL_OFF + 2048;
constexpr int RPB_OFF = LDSCTL_OFF + 6400;
constexpr int WSF_OFF = LDSCTL_OFF + 8448;
constexpr int SEL_OFF = LDSCTL_OFF + 10752;
constexpr int LGS_OFF = LDSCTL_OFF + 12800;
constexpr int LDS_BYTES = 147456;
static_assert(LGS_OFF + 8 * 128 <= LDS_BYTES, "LDS map");

#define GAS __attribute__((address_space(1)))
#define LAS __attribute__((address_space(3)))
typedef unsigned short bf16;
typedef unsigned v4u __attribute__((ext_vector_type(4)));
typedef unsigned v2u __attribute__((ext_vector_type(2)));
typedef float f32x4 __attribute__((ext_vector_type(4)));
typedef float f32x16 __attribute__((ext_vector_type(16)));
typedef short bf16x8 __attribute__((ext_vector_type(8)));
typedef short s16x4 __attribute__((ext_vector_type(4)));
typedef GAS unsigned gu32;
#define RLX_AGENT __ATOMIC_RELAXED, __HIP_MEMORY_SCOPE_AGENT
#define LDS_WAIT() asm volatile("s_waitcnt lgkmcnt(0)" ::: "memory")
#define VM_WAIT() asm volatile("s_waitcnt vmcnt(0)" ::: "memory")
__device__ __forceinline__ unsigned pk2(float lo, float hi) { return pg8::cvt_pk_bf16(lo, hi); }
__device__ __forceinline__ float bf_lo(unsigned w) { return __uint_as_float(w << 16); }
__device__ __forceinline__ float bf_hi(unsigned w) { return __uint_as_float(w & 0xffff0000u); }
__device__ __forceinline__ float wave_sum(float v) {
#pragma unroll
    for (int o = 1; o < 64; o <<= 1) v += __shfl_xor(v, o);
    return v;
}

#define GRD() sgpr_opaque((int)gridDim.x)
#define BLK() sgpr_opaque((int)blockIdx.x)
__device__ __forceinline__ int vcu_of(int G, int bx) { return (G % 8 == 0) ? (bx % 8) * (G / 8) + bx / 8 : bx; }
#define VCU() vcu_of(GRD(), BLK())
#define XB_TMO      128
#define XB_XCNT(j)  (256  + 64 * (j))
#define XB_XSUB(j)  (1280 + 64 * (j))
#define XB_XGEN(j)  (2304 + 64 * (j))
#define XB_TOP      3328
#define XB_TOPGEN   3392
#define XCD_BAR_WORDS 3456
#define XB_SPIN_CAP (1u << 18)

__device__ __forceinline__ unsigned xb_ld(unsigned* p)              { return __hip_atomic_load(p, __ATOMIC_RELAXED, __HIP_MEMORY_SCOPE_AGENT); }
__device__ __forceinline__ unsigned xb_add(unsigned* p, unsigned v) { return __hip_atomic_fetch_add(p, v, __ATOMIC_RELAXED, __HIP_MEMORY_SCOPE_AGENT); }
__device__ __forceinline__ unsigned xb_xcc_id() { return (unsigned)__builtin_amdgcn_s_getreg((3 << 11) | 20) & 0xFu; }
#define XB_SPIN(cond, bar) do { unsigned _sp = 0; while (cond) { __builtin_amdgcn_s_sleep(1); \
    if ((++_sp & 255u) == 0u) { if (xb_ld(&(bar)[XB_TMO])) break; if (_sp > XB_SPIN_CAP) { atomicAdd(&(bar)[XB_TMO], 1u); break; } } } } while (0)

struct XcdBarrier { unsigned* bar; unsigned x; volatile LAS unsigned* st; };

__device__ __forceinline__ XcdBarrier xcd_barrier_post(unsigned* bar, volatile LAS unsigned* st) {
    XcdBarrier b; b.bar = bar; b.x = xb_xcc_id(); b.st = st;
    if (threadIdx.x == 0) (void)xb_add(&bar[XB_XCNT(b.x)], 1u);
    return b;
}
__device__ __forceinline__ void xcd_barrier_complete(unsigned* bar, unsigned x, unsigned& nloc, unsigned& nx) {
    const unsigned G = gridDim.x * gridDim.y * gridDim.z;
    unsigned sum, cnt, mine, sp = 0u;
    for (;;) {
        sum = 0u; cnt = 0u; mine = 0u;
#pragma unroll
        for (unsigned j = 0; j < 16; ++j) { const unsigned c = xb_ld(&bar[XB_XCNT(j)]); sum += c; cnt += (c > 0u) ? 1u : 0u; mine = (j == x) ? c : mine; }
        if (sum == G) break;
        __builtin_amdgcn_s_sleep(1);
        if ((++sp & 255u) == 0u) { if (xb_ld(&bar[XB_TMO])) break; if (sp > XB_SPIN_CAP) { atomicAdd(&bar[XB_TMO], 1u); break; } }
    }
    nloc = mine > 0u ? mine : 1u; nx = cnt > 0u ? cnt : 1u;
}
__device__ __forceinline__ void xcd_barrier(const XcdBarrier& b) {
    asm volatile("s_waitcnt vmcnt(0)" ::: "memory");
    __syncthreads();
    if (threadIdx.x == 0) {
        unsigned* bar = b.bar;
        __builtin_amdgcn_s_waitcnt(0);
        unsigned nloc = b.st[0], nx = b.st[1];
        if (nloc == 0u) { xcd_barrier_complete(bar, b.x, nloc, nx); b.st[0] = nloc; b.st[1] = nx; }
        const unsigned old = xb_add(&bar[XB_XSUB(b.x)], 1u);
        const unsigned gen = old / nloc;
        if (old + 1u == (gen + 1u) * nloc) {
            __builtin_amdgcn_fence(__ATOMIC_RELEASE, "agent");
            asm volatile("s_waitcnt vmcnt(0)" ::: "memory");
            const unsigned og = xb_add(&bar[XB_TOP], 1u);
            const unsigned tg = og / nx;
            if (og + 1u == (tg + 1u) * nx) xb_add(&bar[XB_TOPGEN], 1u);
            else XB_SPIN(xb_ld(&bar[XB_TOPGEN]) == tg, bar);
            __builtin_amdgcn_fence(__ATOMIC_ACQUIRE, "agent");
            xb_add(&bar[XB_XGEN(b.x)], 1u);
            asm volatile("s_waitcnt vmcnt(0)" ::: "memory");
        } else {
            XB_SPIN(xb_ld(&bar[XB_XGEN(b.x)]) == gen, bar);
            __builtin_amdgcn_fence(__ATOMIC_ACQUIRE, "agent");
            asm volatile("s_waitcnt vmcnt(0)" ::: "memory");
        }
    }
    __syncthreads();
}

struct Params { const float* in[20]; float* out; unsigned char* ws; int ph_lo, ph_hi; };
typedef const __attribute__((address_space(4))) Params* KP;
enum { I_X = 0, I_WIN, I_WOUT, I_LQ1, I_LK1, I_LQ2, I_LK2, I_SUBLN, I_T5, I_RPB, I_LN1G, I_LN1B, I_RW, I_RB, I_WGU, I_BGU, I_WDN, I_BDN, I_LN2G, I_LN2B };

__device__ __forceinline__ void transpose_item(const float* Wsrc  , size_t ldw, bf16* WTdst  , int K, LAS unsigned* scr, int lane) {
    const int l31 = lane & 31, kh = lane >> 5;
    const float* src = Wsrc + (size_t)(2 * kh) * ldw + 4 * l31;
#pragma unroll
    for (int half = 0; half < 2; ++half) {
        f32x4 v0[8], v1[8];
#pragma unroll
        for (int i = 0; i < 8; ++i) { const float* p = src + (size_t)(4 * (8 * half + i)) * ldw; v0[i] = *(const f32x4*)p; v1[i] = *(const f32x4*)(p + ldw); }
#pragma unroll
        for (int i = 0; i < 8; ++i) { const int kp = 2 * (8 * half + i) + kh;
            const int col = kp ^ ((l31 & 7) << 2);
#pragma unroll
            for (int j = 0; j < 4; ++j) scr[(4 * l31 + j) * 32 + col] = pk2(v0[i][j], v1[i][j]); }
    }
    LDS_WAIT(); asm volatile("" ::: "memory");
#pragma unroll
    for (int i2 = 0; i2 < 16; ++i2) { const int n = 8 * i2 + (lane >> 3), c = lane & 7, cs = c ^ ((n >> 2) & 7);
        const v4u o = *(const LAS v4u*)(scr + n * 32 + 4 * cs);
        *(v4u*)(WTdst + (size_t)n * K + 8 * c) = o; }
    LDS_WAIT(); asm volatile("" ::: "memory");
}
__device__ __forceinline__ void p0_prologue(KP P, LAS unsigned char* lds, int vcu, int G, int wave, int lane) {
    LAS unsigned* scr = (LAS unsigned*)(lds + RING_OFF + wave * 16384);
    const int gw = vcu * NWAVES + wave, NGW = G * NWAVES;
    unsigned char* ws = P->ws;
    constexpr int I_GU = 2 * 32 * 256, I_DN = 2 * 32 * 128, I_IN = 2 * 384, I_OUT = 2 * 128, NITEMS = I_GU + I_DN + I_IN + I_OUT;
    for (int it = gw; it < NITEMS; it += NGW) {
        int r = it;
        if (r < I_GU) { const int le = r >> 8, kt = (r >> 4) & 15, nt = r & 15;
            const float* W = P->in[I_WGU] + (size_t)le * 1024 * 2048;
            const int n0 = nt * 128; const int orow = (n0 < 1024) ? (256 * (n0 >> 7)) : (256 * ((n0 - 1024) >> 7) + 128);
            bf16* WT = (bf16*)(ws + WS_WGU) + (size_t)le * 2048 * 1024;
            transpose_item(W + (size_t)(kt * 64) * 2048 + n0, 2048, WT + (size_t)orow * 1024 + kt * 64, 1024, scr, lane); continue; }
        r -= I_GU;
        if (r < I_DN) { const int le = r >> 7, kt = (r >> 3) & 15, nt = r & 7;
            const float* W = P->in[I_WDN] + (size_t)le * 1024 * 1024;
            bf16* WT = (bf16*)(ws + WS_WDN) + (size_t)le * 1024 * 1024;
            transpose_item(W + (size_t)(kt * 64) * 1024 + nt * 128, 1024, WT + (size_t)(nt * 128) * 1024 + kt * 64, 1024, scr, lane); continue; }
        r -= I_DN;
        if (r < I_IN) { const int l = r / 384, q = r % 384, kt = q / 24, nt = q % 24;
            const float* W = P->in[I_WIN] + (size_t)l * 1024 * 3072;
            bf16* WT = (bf16*)(ws + WS_WIN) + (size_t)l * 3072 * 1024;
            transpose_item(W + (size_t)(kt * 64) * 3072 + nt * 128, 3072, WT + (size_t)(nt * 128) * 1024 + kt * 64, 1024, scr, lane); continue; }
        r -= I_IN;
        { const int l = r >> 7, kt = (r >> 3) & 15, nt = r & 7;
            const float* W = P->in[I_WOUT] + (size_t)l * 1024 * 1024;
            bf16* WT = (bf16*)(ws + WS_WOUT) + (size_t)l * 1024 * 1024;
            transpose_item(W + (size_t)(kt * 64) * 1024 + nt * 128, 1024, WT + (size_t)(nt * 128) * 1024 + kt * 64, 1024, scr, lane); }
    }
    const f32x4* x4 = (const f32x4*)P->in[I_X]; v4u* xb = (v4u*)(ws + WS_XB);
    const size_t nchunk = (size_t)T * D / 8, gt = (size_t)gw * 64 + lane, ngt = (size_t)NGW * 64;
    for (size_t i = gt; i < nchunk; i += ngt) { const f32x4 a = x4[2 * i], b = x4[2 * i + 1]; v4u o; o.x = pk2(a[0], a[1]); o.y = pk2(a[2], a[3]); o.z = pk2(b[0], b[1]); o.w = pk2(b[2], b[3]); xb[i] = o; }
}

namespace att {
__device__ __forceinline__ int crow(int r, int hi) { return (r & 3) + 8 * (r >> 2) + 4 * hi; }
__device__ __forceinline__ void glds16(const void* gsrc, LAS unsigned char* lds_dst) {
    __builtin_amdgcn_global_load_lds((const unsigned*)gsrc, (LAS unsigned*)lds_dst, 16, 0, 0); }
typedef short v4i16_t __attribute__((ext_vector_type(4)));
__device__ __forceinline__ s16x4 vtr(const LAS char* p) { return __builtin_bit_cast(s16x4, __builtin_amdgcn_ds_read_tr16_b64_v4i16((LAS v4i16_t*)p)); }
#define ATT_WAIT_BAR() asm volatile("s_waitcnt vmcnt(0) lgkmcnt(0)\n\ts_barrier" ::: "memory")
constexpr float THR = 8.0f;

__device__ __forceinline__ void qkt(f32x16& p0, f32x16& p1, const LAS char* kb, const bf16x8 (&qr)[4], float ci) {
    f32x16 c;
#pragma unroll
    for (int r = 0; r < 16; ++r) c[r] = ci;
#pragma unroll
    for (int d0 = 0; d0 < 4; ++d0) {
        const bf16x8 b0 = *(const LAS bf16x8*)(kb + d0 * 2048);
        const bf16x8 b1 = *(const LAS bf16x8*)(kb + d0 * 2048 + 512);
        if (d0 == 0) { p0 = __builtin_amdgcn_mfma_f32_32x32x16_bf16(b0, qr[0], c, 0, 0, 0); p1 = __builtin_amdgcn_mfma_f32_32x32x16_bf16(b1, qr[0], c, 0, 0, 0); }
        else { p0 = __builtin_amdgcn_mfma_f32_32x32x16_bf16(b0, qr[d0], p0, 0, 0, 0); p1 = __builtin_amdgcn_mfma_f32_32x32x16_bf16(b1, qr[d0], p1, 0, 0, 0); }
    }
}
template <int NEB>
__device__ __forceinline__ void softmax_pv(f32x16& p0, f32x16& p1, float& mhat, float& lsum, f32x16 (&o)[NEB], bool force, volatile LAS float* wsf, const LAS char* vb, int r32, int hi) {
    float rm = fmaxf(p0[0], p1[0]);
#pragma unroll
    for (int r = 1; r < 16; ++r) rm = fmaxf(rm, fmaxf(p0[r], p1[r]));
    { auto rr = __builtin_amdgcn_permlane32_swap(__float_as_uint(rm), __float_as_uint(rm), false, false); rm = fmaxf(__uint_as_float(rr[0]), __uint_as_float(rr[1])); }
    if (force || __any(rm > THR)) {
        const float dl = force ? rm : fmaxf(rm, 0.f);
        mhat += dl;
#pragma unroll
        for (int r = 0; r < 16; ++r) { p0[r] -= dl; p1[r] -= dl; }
        if (!force) {
            const float f = __builtin_amdgcn_exp2f(-dl);
            lsum *= f;
            if (hi == 0) wsf[r32] = f;
            LDS_WAIT();
#pragma unroll
            for (int r = 0; r < 16; ++r) { const float fr = wsf[crow(r, hi)];
#pragma unroll
                for (int d = 0; d < NEB; ++d) o[d][r] *= fr; }
        }
    }
    float s = 0.f;
#pragma unroll
    for (int r = 0; r < 16; ++r) { p0[r] = __builtin_amdgcn_exp2f(p0[r]); p1[r] = __builtin_amdgcn_exp2f(p1[r]); s += p0[r] + p1[r]; }
    lsum += s;
    v4u pw[4];
    pw[0] = (v4u){pk2(p0[0], p0[1]), pk2(p0[2], p0[3]), pk2(p0[4], p0[5]), pk2(p0[6], p0[7])};
    pw[1] = (v4u){pk2(p0[8], p0[9]), pk2(p0[10], p0[11]), pk2(p0[12], p0[13]), pk2(p0[14], p0[15])};
    pw[2] = (v4u){pk2(p1[0], p1[1]), pk2(p1[2], p1[3]), pk2(p1[4], p1[5]), pk2(p1[6], p1[7])};
    pw[3] = (v4u){pk2(p1[8], p1[9]), pk2(p1[10], p1[11]), pk2(p1[12], p1[13]), pk2(p1[14], p1[15])};
#pragma unroll
    for (int d0 = 0; d0 < NEB; ++d0)
#pragma unroll
        for (int ks = 0; ks < 4; ++ks) {
            const s16x4 lo = vtr(vb + d0 * 4096 + ks * 1024), hh = vtr(vb + d0 * 4096 + ks * 1024 + 512);
            const bf16x8 vf = (bf16x8){lo[0], lo[1], lo[2], lo[3], hh[0], hh[1], hh[2], hh[3]};
            o[d0] = __builtin_amdgcn_mfma_f32_32x32x16_bf16(__builtin_bit_cast(bf16x8, pw[ks]), vf, o[d0], 0, 0, 0);
        }
}

__device__ __forceinline__ void da_unit(int b, int h, int qb, const bf16* HB, bf16* OB, LAS unsigned char* lds, float lam, float out_scale, const float* subln_g) {
    const int tid = tid_opaque(), lane = tid & 63, r32 = lane & 31, hi = lane >> 5; const int wid = __builtin_amdgcn_readfirstlane(tid >> 6);
    const int br = wid >> 2, qw = wid & 3;
    const size_t rowbase = (size_t)b * SEQ; const int q0 = qb * 128, q0w = q0 + qw * 32;
    const bf16* Qw = HB + (rowbase + q0w) * PW + br * 256 + h * 64;
    const bf16* Kh = HB + rowbase * PW + 512 + br * 256 + h * 64;
    const bf16* Vh = HB + rowbase * PW + 1024 + h * 128;
    volatile LAS float* wsf = (volatile LAS float*)(lds + WSF_OFF) + wid * 64;
    const LAS float* bt = (const LAS float*)(lds + BTAB_OFF) + h * 260;
    const bf16* ksrc0 = Kh + (size_t)lane * PW + (2 * qw) * 8;
    const int vp0 = 2 * wid, vp1 = 2 * wid + 1;
    const bf16* vsrc0 = Vh + (size_t)(16 * (vp0 & 3) + (lane >> 2)) * PW + 32 * (vp0 >> 2) + (lane & 3) * 8;
    const bf16* vsrc1 = Vh + (size_t)(16 * (vp1 & 3) + (lane >> 2)) * PW + 32 * (vp1 >> 2) + (lane & 3) * 8;
    LAS unsigned char* kdst = lds + br * 8192 + (2 * qw) * 1024; LAS unsigned char* vdst = lds + 16384 + vp0 * 1024;
#define DA_DMA(t, slot) do { const size_t to_ = (size_t)(t) * 64 * PW; \
        glds16(ksrc0 + to_, kdst + (slot)); glds16(ksrc0 + to_ + 8, kdst + (slot) + 1024); \
        glds16(vsrc0 + to_, vdst + (slot)); glds16(vsrc1 + to_, vdst + (slot) + 1024); } while (0)
    DA_DMA(0, 0);
    bf16x8 qr[4];
#pragma unroll
    for (int d0 = 0; d0 < 4; ++d0) qr[d0] = *(const bf16x8*)(Qw + (size_t)r32 * PW + d0 * 16 + hi * 8);
    float mhat = 0.f, lsum = 0.f; f32x16 o[4];
#pragma unroll
    for (int d = 0; d < 4; ++d)
#pragma unroll
        for (int r = 0; r < 16; ++r) o[d][r] = 0.f;
    const float bneg = bt[0], bpos = bt[256];
    const LAS char* kb0 = (const LAS char*)lds + br * 8192 + hi * 1024 + r32 * 16;
    const LAS char* vb0 = (const LAS char*)lds + 16384 + ((lane >> 4) & 1) * 32 + (lane & 3) * 8 + (4 * hi + ((lane & 15) >> 2)) * 64;
    ATT_WAIT_BAR();
    constexpr int NT = SEQ / 64;
    for (int t = 0; t < NT; ++t) {
        const int cur = (t & 1) * 32768;
        if (t + 1 < NT) DA_DMA(t + 1, cur ^ 32768);
        const int relmin = 64 * t - (q0w + 31), relmax = 64 * t + 63 - q0w;
        const bool diag = !(relmax <= -128 || relmin >= 128);
        const float bc = diag ? 0.f : (relmax <= -128 ? bneg : bpos);
        f32x16 p0, p1;
        qkt(p0, p1, kb0 + cur, qr, bc - mhat);
        if (diag) {
            const int base = 64 * t - q0w - r32 + 4 * hi;
#pragma unroll
            for (int r = 0; r < 16; ++r) { const int rel = base + (r & 3) + 8 * (r >> 2);
                const int i0 = min(max(rel, -128), 128) + 128, i1 = min(max(rel + 32, -128), 128) + 128;
                p0[r] += bt[i0]; p1[r] += bt[i1]; }
        }
        softmax_pv<4>(p0, p1, mhat, lsum, o, t == 0, wsf, vb0 + cur, r32, hi);
        ATT_WAIT_BAR();
    }
#undef DA_DMA
    { auto rr = __builtin_amdgcn_permlane32_swap(__float_as_uint(lsum), __float_as_uint(lsum), false, false); lsum = __uint_as_float(rr[0]) + __uint_as_float(rr[1]); }
    if (hi == 0) wsf[32 + r32] = 1.0f / lsum;
    LDS_WAIT();
    LAS float* ex = (LAS float*)lds + wid * 4096;
#pragma unroll
    for (int r = 0; r < 16; ++r) { const int row = crow(r, hi); const float rl = wsf[32 + row];
#pragma unroll
        for (int d = 0; d < 4; ++d) ex[row * 128 + d * 32 + r32] = o[d][r] * rl; }
    asm volatile("s_waitcnt lgkmcnt(0)\n\ts_barrier" ::: "memory");
    {
        const float g0 = subln_g[2 * lane], g1 = subln_g[2 * lane + 1];
#pragma unroll 4
        for (int j = 0; j < 16; ++j) { const int qi = wid * 16 + j, w1 = qi >> 5, rr_ = qi & 31;
            const LAS float* e1 = (const LAS float*)lds + w1 * 4096 + rr_ * 128 + 2 * lane; const LAS float* e2 = e1 + 4 * 4096;
            const float d0v = e1[0] - lam * e2[0], d1v = e1[1] - lam * e2[1];
            const float ss = wave_sum(d0v * d0v + d1v * d1v);
            const float rs = __builtin_amdgcn_rsqf(ss * (1.0f / 128.0f) + DA_EPS) * out_scale;
            *(unsigned*)(OB + (rowbase + q0 + qi) * D + h * 128 + 2 * lane) = pk2(d0v * rs * g0, d1v * rs * g1); }
    }
    asm volatile("s_waitcnt lgkmcnt(0)\n\ts_barrier" ::: "memory");
}

__device__ __forceinline__ void na_unit(int b, int h, int g, const bf16* HB, bf16* OB, LAS unsigned char* lds, const float* rpb_lh  ) {
    const int tid = tid_opaque(), lane = tid & 63, r32 = lane & 31, hi = lane >> 5; const int wid = __builtin_amdgcn_readfirstlane(tid >> 6);
    const int gr = 4 * g + (wid >> 1), hq = wid & 1;
    const size_t rowbase = (size_t)b * SEQ;
    volatile LAS float* wsf = (volatile LAS float*)(lds + WSF_OFF) + wid * 64;
    LAS float* rp = (LAS float*)(lds + RPB_OFF);
    if (tid < 465) rp[tid] = rpb_lh[tid] * LOG2E;
    const int ulo = min(max(4 * g - 4, 0), GROWS - 8), uhi = min(max(4 * g - 1, 0), GROWS - 8) + 8, NT = uhi - ulo;
    const int rs = min(max(gr - 4, 0), GROWS - 8);
    const bf16* Qw = HB + (rowbase + (size_t)gr * 64 + hq * 32) * PW + 1536 + h * 64;
    const bf16* ksrc = HB + (rowbase + (size_t)ulo * 64 + lane) * PW + 2048 + h * 64 + wid * 8;
    const bf16* vsrc = HB + (rowbase + (size_t)ulo * 64 + 16 * (wid & 3) + (lane >> 2)) * PW + 2560 + h * 64 + 32 * (wid >> 2) + (lane & 3) * 8;
    LAS unsigned char* kdst = lds + wid * 1024; LAS unsigned char* vdst = lds + 8192 + wid * 1024;
#define NA_DMA(t, slot) do { const size_t to_ = (size_t)(t) * 64 * PW; glds16(ksrc + to_, kdst + (slot)); glds16(vsrc + to_, vdst + (slot)); } while (0)
    NA_DMA(0, 0);
    bf16x8 qr[4];
#pragma unroll
    for (int d0 = 0; d0 < 4; ++d0) qr[d0] = *(const bf16x8*)(Qw + (size_t)r32 * PW + d0 * 16 + hi * 8);
    float mhat = 0.f, lsum = 0.f; f32x16 o[2];
#pragma unroll
    for (int d = 0; d < 2; ++d)
#pragma unroll
        for (int r = 0; r < 16; ++r) o[d][r] = 0.f;
    const LAS char* kb0 = (const LAS char*)lds + hi * 1024 + r32 * 16;
    const LAS char* vb0 = (const LAS char*)lds + 8192 + ((lane >> 4) & 1) * 32 + (lane & 3) * 8 + (4 * hi + ((lane & 15) >> 2)) * 64;
    const int qc = hq * 32 + r32, cs = min(max(qc - 8, 0), GRIDW - 16);
    ATT_WAIT_BAR();
    bool first = true;
    for (int t = 0; t < NT; ++t) {
        const int cur = (t & 1) * 16384;
        if (t + 1 < NT) NA_DMA(t + 1, cur ^ 16384);
        const int u = ulo + t;
        if (u >= rs && u < rs + 8) {
            f32x16 p0, p1;
            qkt(p0, p1, kb0 + cur, qr, -mhat);
            const int ro = (u - gr + 7) * 31 + 15 - qc;
#pragma unroll
            for (int r = 0; r < 16; ++r) { const int kc0 = crow(r, hi), kc1 = kc0 + 32;
                const bool ok0 = (unsigned)(kc0 - cs) < 16u, ok1 = (unsigned)(kc1 - cs) < 16u;
                const float b0 = rp[ok0 ? ro + kc0 : 0], b1 = rp[ok1 ? ro + kc1 : 0];
                p0[r] = ok0 ? p0[r] + b0 : -INFINITY; p1[r] = ok1 ? p1[r] + b1 : -INFINITY; }
            softmax_pv<2>(p0, p1, mhat, lsum, o, first, wsf, vb0 + cur, r32, hi);
            first = false;
        }
        ATT_WAIT_BAR();
    }
#undef NA_DMA
    { auto rr = __builtin_amdgcn_permlane32_swap(__float_as_uint(lsum), __float_as_uint(lsum), false, false); lsum = __uint_as_float(rr[0]) + __uint_as_float(rr[1]); }
    if (hi == 0) wsf[32 + r32] = 1.0f / lsum;
    LDS_WAIT();
    LAS bf16* stg = (LAS bf16*)(lds + 65536) + wid * 2048;
#pragma unroll
    for (int r = 0; r < 16; ++r) { const int row = crow(r, hi); const float rl = wsf[32 + row];
#pragma unroll
        for (int d = 0; d < 2; ++d) stg[row * 64 + d * 32 + r32] = (bf16)(pk2(o[d][r] * rl, 0.f) & 0xffffu); }
    LDS_WAIT();
    bf16* Ow = OB + (rowbase + (size_t)gr * 64 + hq * 32) * D + 512 + h * 64;
#pragma unroll
    for (int i = 0; i < 4; ++i) { const int row = i * 8 + (lane >> 3), ch = lane & 7; const v4u v = *(const LAS v4u*)(stg + row * 64 + ch * 8); *(v4u*)(Ow + (size_t)row * D + ch * 8) = v; }
    asm volatile("s_waitcnt lgkmcnt(0)\n\ts_barrier" ::: "memory");
}

__device__ __forceinline__ int t5_bucket(int rel) {
    const int n = rel < 0 ? -rel : rel; int ret = rel > 0 ? 16 : 0;
    if (n < 8) return ret + n;
    const float v = logf((float)n / 8.0f) / 2.772588722239781f * 8.0f;
    int large = 8 + (int)v; large = large < 15 ? large : 15;
    return ret + large;
}
__device__ __forceinline__ void attn_phase(KP P, int l, LAS unsigned char* lds, int vcu, int G) {
    const int tid = tid_opaque(), lane = tid & 63;
    unsigned char* ws = P->ws;
    const bf16* HB = (const bf16*)(ws + WS_HB); bf16* OB = (bf16*)(ws + WS_OB);
    { LAS float* bt = (LAS float*)(lds + BTAB_OFF);
      for (int i = tid; i < 4 * 257; i += NWAVES * 64) { const int hh = i / 257, j = i % 257; bt[hh * 260 + j] = P->in[I_T5][t5_bucket(j - 128) * 4 + hh] * LOG2E; } }
    const float lam_init = 0.8f - 0.6f * expf(-0.3f * (float)l);
    const float d1 = wave_sum(P->in[I_LQ1][l * 64 + lane] * P->in[I_LK1][l * 64 + lane]);
    const float d2 = wave_sum(P->in[I_LQ2][l * 64 + lane] * P->in[I_LK2][l * 64 + lane]);
    const float lam = expf(d1) - expf(d2) + lam_init;
    __syncthreads();
    for (int U = vcu; U < 16 * 64; U += G) { const int bh = U >> 6, qb = U & 63; da_unit(bh >> 2, bh & 3, qb, HB, OB, lds, lam, 1.0f - lam_init, P->in[I_SUBLN] + l * 128); }
    for (int U = vcu; U < 4 * 8 * 32; U += G) { const int bh = U >> 5, g = U & 31; na_unit(bh >> 3, bh & 7, g, HB, OB, lds, P->in[I_RPB] + ((size_t)l * 8 + (bh & 7)) * 465); }
}
}

__device__ __forceinline__ void ln_router_phase(KP P, int l, LAS unsigned char* lds, int G, int wave, int lane) {
    const int tid = tid_opaque();
    unsigned char* ws = P->ws;
    const float* PRE = (const float*)(ws + WS_PRE); float* X1F = (float*)(ws + WS_X1F); bf16* X1B = (bf16*)(ws + WS_X1B);
    int* TKE = (int*)(ws + WS_TKE); float* TKG = (float*)(ws + WS_TKG); int* SLOT = (int*)(ws + WS_SLOT); int* TOKL = (int*)(ws + WS_TOKL);
    unsigned* cnt = (unsigned*)(ws + WS_CTL) + CW_CNT + 64 * l;
    { const f32x4* rw4 = (const f32x4*)(P->in[I_RW] + (size_t)l * 1024 * 32); LAS f32x4* L4 = (LAS f32x4*)lds;
      for (int i = tid; i < 1024 * 8; i += NWAVES * 64) { const int d = i >> 3, c = i & 7; L4[d * 8 + (c ^ ((d >> 2) & 7))] = rw4[i]; } }
    f32x4 gv[4], bv[4];
#pragma unroll
    for (int j = 0; j < 4; ++j) { gv[j] = *(const f32x4*)(P->in[I_LN1G] + l * 1024 + 256 * j + 4 * lane); bv[j] = *(const f32x4*)(P->in[I_LN1B] + l * 1024 + 256 * j + 4 * lane); }
    const float rbias = P->in[I_RB][l * 32 + (lane >> 1)];
    LAS int* sel = (LAS int*)(lds + SEL_OFF);
    __syncthreads();
    for (int chunk = BLK(); chunk < T / 128; chunk += G) {
        for (int rr = 0; rr < 16; ++rr) {
            const int rloc = wave * 16 + rr; const size_t row = (size_t)chunk * 128 + rloc;
            f32x4 v[4]; float s = 0.f;
#pragma unroll
            for (int j = 0; j < 4; ++j) { v[j] = *(const f32x4*)(PRE + row * D + 256 * j + 4 * lane); s += (v[j][0] + v[j][1]) + (v[j][2] + v[j][3]); }
            const float mean = wave_sum(s) * (1.f / D); float s2 = 0.f;
#pragma unroll
            for (int j = 0; j < 4; ++j) { v[j] = v[j] - mean; s2 += (v[j][0] * v[j][0] + v[j][1] * v[j][1]) + (v[j][2] * v[j][2] + v[j][3] * v[j][3]); }
            const float rstd = 1.f / sqrtf(wave_sum(s2) * (1.f / D) + LN_EPS);
#pragma unroll
            for (int j = 0; j < 4; ++j) { v[j] = v[j] * rstd * gv[j] + bv[j];
                *(f32x4*)(X1F + row * D + 256 * j + 4 * lane) = v[j];
                v2u o; o.x = pk2(v[j][0], v[j][1]); o.y = pk2(v[j][2], v[j][3]); *(v2u*)(X1B + row * D + 256 * j + 4 * lane) = o; }
            float acc[32];
#pragma unroll
            for (int e = 0; e < 32; ++e) acc[e] = 0.f;
#pragma unroll
            for (int j = 0; j < 4; ++j)
#pragma unroll
                for (int i = 0; i < 4; ++i) { const int d = 256 * j + 4 * lane + i; const LAS f32x4* wr = (const LAS f32x4*)lds + d * 8; const float xv = v[j][i];
#pragma unroll
                    for (int c = 0; c < 8; ++c) { const f32x4 w = wr[c ^ (lane & 7)];
                        acc[4 * c + 0] += xv * w[0]; acc[4 * c + 1] += xv * w[1]; acc[4 * c + 2] += xv * w[2]; acc[4 * c + 3] += xv * w[3]; } }
            float a16[16], a8[8], a4[4], a2[2], a1;
            { const bool hb = (lane & 32) != 0;
#pragma unroll
              for (int k = 0; k < 16; ++k) { const float mine = hb ? acc[16 + k] : acc[k], oth = hb ? acc[k] : acc[16 + k]; a16[k] = mine + __shfl_xor(oth, 32); } }
            { const bool hb = (lane & 16) != 0;
#pragma unroll
              for (int k = 0; k < 8; ++k) { const float mine = hb ? a16[8 + k] : a16[k], oth = hb ? a16[k] : a16[8 + k]; a8[k] = mine + __shfl_xor(oth, 16); } }
            { const bool hb = (lane & 8) != 0;
#pragma unroll
              for (int k = 0; k < 4; ++k) { const float mine = hb ? a8[4 + k] : a8[k], oth = hb ? a8[k] : a8[4 + k]; a4[k] = mine + __shfl_xor(oth, 8); } }
            { const bool hb = (lane & 4) != 0;
#pragma unroll
              for (int k = 0; k < 2; ++k) { const float mine = hb ? a4[2 + k] : a4[k], oth = hb ? a4[k] : a4[2 + k]; a2[k] = mine + __shfl_xor(oth, 4); } }
            { const bool hb = (lane & 2) != 0; const float mine = hb ? a2[1] : a2[0], oth = hb ? a2[0] : a2[1]; a1 = mine + __shfl_xor(oth, 2); }
            a1 += __shfl_xor(a1, 1);
            float lgv = a1 + rbias; int si[4]; float sv[4];
#pragma unroll
            for (int k = 0; k < 4; ++k) { float mx = lgv;
#pragma unroll
                for (int o = 1; o < 64; o <<= 1) mx = fmaxf(mx, __shfl_xor(mx, o));
                const unsigned long long bm = __ballot(lgv == mx); const int fl = __builtin_ctzll(bm);
                si[k] = fl >> 1; sv[k] = mx; if ((lane >> 1) == (fl >> 1)) lgv = -INFINITY; }
            const float e1 = expf(sv[1] - sv[0]), e2 = expf(sv[2] - sv[0]), e3 = expf(sv[3] - sv[0]); const float inv = 1.0f / (1.0f + e1 + e2 + e3);
            if (lane == 0) { *(f32x4*)(TKG + row * 4) = (f32x4){inv, e1 * inv, e2 * inv, e3 * inv};
                *(v4u*)(TKE + row * 4) = (v4u){(unsigned)si[0], (unsigned)si[1], (unsigned)si[2], (unsigned)si[3]};
                sel[rloc * 4 + 0] = si[0]; sel[rloc * 4 + 1] = si[1]; sel[rloc * 4 + 2] = si[2]; sel[rloc * 4 + 3] = si[3]; }
            LDS_WAIT();
        }
        __syncthreads();
        for (int ee = 0; ee < 4; ++ee) { const int e = wave * 4 + ee; int total = 0;
            for (int ch = 0; ch < 8; ++ch) { const unsigned long long m = __ballot(sel[ch * 64 + lane] == e); total += __popcll(m); }
            unsigned base = 0; if (lane == 0 && total > 0) base = xb_add(cnt + e, (unsigned)total);
            base = (unsigned)__builtin_amdgcn_readfirstlane((int)base);
            int run = 0;
            for (int ch = 0; ch < 8; ++ch) { const bool mt = sel[ch * 64 + lane] == e; const unsigned long long m = __ballot(mt);
                if (mt) { const int pos = (int)base + run + __popcll(m & ((1ull << lane) - 1ull)); const int id = chunk * 512 + ch * 64 + lane; TOKL[(size_t)e * T + pos] = id; SLOT[id] = pos; }
                run += __popcll(m); } }
        __syncthreads();
    }
}

__device__ __forceinline__ void sort_phase(KP P, int l, LAS unsigned char* lds, int vcu, int G, int wave, int lane) {
    unsigned char* ws = P->ws;
    LAS int* poff = (LAS int*)(lds + POFF_OFF); LAS unsigned char* te = lds + TILEE_OFF;
    unsigned* cnt = (unsigned*)(ws + WS_CTL) + CW_CNT + 64 * l;
    LAS int* ecnt = (LAS int*)(lds + ECNT_OFF);
    if (threadIdx.x == 0) { int off = 0;
        _Pragma("nounroll") for (int e = 0; e < NE; ++e) { poff[e] = off; int c = (int)xb_ld(cnt + e); c = c > T ? T : c; ecnt[e] = c; const int nt = (c + 255) >> 8; _Pragma("nounroll") for (int i = 0; i < nt; ++i) ((volatile LAS unsigned char*)te)[(off >> 8) + i] = (unsigned char)e; off += nt << 8; }
        poff[NE] = off; }
    __syncthreads();
    const int* TOKL = (const int*)(ws + WS_TOKL); const bf16* X1B = (const bf16*)(ws + WS_X1B); bf16* XS = (bf16*)(ws + WS_XS);
    const int MP = poff[NE];
    for (int s = vcu * NWAVES + wave; s < MP; s += G * NWAVES) {
        const int e = (int)te[s >> 8]; const int i = s - poff[e]; const int c = ecnt[e];
        v4u a = (v4u){0u, 0u, 0u, 0u}, b2 = a;
        if (i < c) { const int id = TOKL[(size_t)e * T + i]; const v4u* src = (const v4u*)(X1B + (size_t)(id >> 2) * D); a = src[lane]; b2 = src[64 + lane]; }
        v4u* dst = (v4u*)(XS + (size_t)s * D); dst[lane] = a; dst[64 + lane] = b2;
    }
}

__device__ __forceinline__ void combine_phase(KP P, int l, LAS unsigned char* lds, int vcu, int G, int wave, int lane) {
    unsigned char* ws = P->ws;
    const LAS int* poff = (const LAS int*)(lds + POFF_OFF);
    const float* X1F = (const float*)(ws + WS_X1F); const bf16* Y = (const bf16*)(ws + WS_Y);
    const int* TKE = (const int*)(ws + WS_TKE); const float* TKG = (const float*)(ws + WS_TKG); const int* SLOT = (const int*)(ws + WS_SLOT);
    float* OUT = (l == DEPTH - 1) ? P->out : (float*)(ws + WS_X2F); bf16* XB = (bf16*)(ws + WS_XB);
    f32x4 gv[4], bv[4];
#pragma unroll
    for (int j = 0; j < 4; ++j) { gv[j] = *(const f32x4*)(P->in[I_LN2G] + l * 1024 + 256 * j + 4 * lane); bv[j] = *(const f32x4*)(P->in[I_LN2B] + l * 1024 + 256 * j + 4 * lane); }
    for (int row = vcu * NWAVES + wave; row < T; row += G * NWAVES) {
        const v4u ei = *(const v4u*)(TKE + (size_t)row * 4), sl = *(const v4u*)(SLOT + (size_t)row * 4); const f32x4 gt = *(const f32x4*)(TKG + (size_t)row * 4);
        f32x4 v[4];
#pragma unroll
        for (int j = 0; j < 4; ++j) v[j] = *(const f32x4*)(X1F + (size_t)row * D + 256 * j + 4 * lane) * DN_ALPHA;
#pragma unroll
        for (int k = 0; k < 4; ++k) { const int e = (int)ei[k] & 31; const size_t srow = (size_t)(poff[e] + (int)sl[k]); const float gk = gt[k];
#pragma unroll
            for (int j = 0; j < 4; ++j) { const v2u y = *(const v2u*)(Y + srow * D + 256 * j + 4 * lane);
                v[j][0] += gk * bf_lo(y.x); v[j][1] += gk * bf_hi(y.x); v[j][2] += gk * bf_lo(y.y); v[j][3] += gk * bf_hi(y.y); } }
        float s = 0.f;
#pragma unroll
        for (int j = 0; j < 4; ++j) s += (v[j][0] + v[j][1]) + (v[j][2] + v[j][3]);
        const float mean = wave_sum(s) * (1.f / D); float s2 = 0.f;
#pragma unroll
        for (int j = 0; j < 4; ++j) { v[j] = v[j] - mean; s2 += (v[j][0] * v[j][0] + v[j][1] * v[j][1]) + (v[j][2] * v[j][2] + v[j][3] * v[j][3]); }
        const float rstd = 1.f / sqrtf(wave_sum(s2) * (1.f / D) + LN_EPS);
#pragma unroll
        for (int j = 0; j < 4; ++j) { v[j] = v[j] * rstd * gv[j] + bv[j];
            *(f32x4*)(OUT + (size_t)row * D + 256 * j + 4 * lane) = v[j];
            v2u o; o.x = pk2(v[j][0], v[j][1]); o.y = pk2(v[j][2], v[j][3]); *(v2u*)(XB + (size_t)row * D + 256 * j + 4 * lane) = o; }
    }
}

#define KPARAMS() ({ KP q_ = (KP)__builtin_amdgcn_kernarg_segment_ptr(); asm volatile("" : "+s"(q_)); q_; })

__device__ __forceinline__ void seam(KP P, LAS unsigned char* lds, int k) {
    if (MK_N_LAUNCHES != 1) return;
    if (!(P->ph_lo <= k && k + 1 < P->ph_hi)) return;
    XcdBarrier b; b.bar = (unsigned*)(P->ws + WS_CTL) + CW_BAR; b.x = xb_xcc_id(); b.st = (volatile LAS unsigned*)(lds + MISC_OFF) + 8;
    xcd_barrier(b);
}
__device__ __forceinline__ void build_offsets(KP P, int l, LAS unsigned char* lds) {
    LAS int* poff = (LAS int*)(lds + POFF_OFF); LAS unsigned char* te = lds + TILEE_OFF; LAS int* ecnt = (LAS int*)(lds + ECNT_OFF);
    unsigned* cnt = (unsigned*)(P->ws + WS_CTL) + CW_CNT + 64 * l;
    if (threadIdx.x == 0) { int off = 0;
        _Pragma("nounroll") for (int e = 0; e < NE; ++e) { poff[e] = off; int c = (int)xb_ld(cnt + e); c = c > T ? T : c; ecnt[e] = c; const int nt = (c + 255) >> 8; _Pragma("nounroll") for (int i = 0; i < nt; ++i) ((volatile LAS unsigned char*)te)[(off >> 8) + i] = (unsigned char)e; off += nt << 8; }
        poff[NE] = off; }
    __syncthreads();
}
__global__ void __launch_bounds__(NWAVES * 64, 2) mk_fwd(Params Pv) {
    extern __shared__ __attribute__((aligned(16))) unsigned char lds_raw[];
    LAS unsigned char* lds0_ = (LAS unsigned char*)lds_raw;
#define LDSP() ({ LAS unsigned char* p_ = lds0_; asm volatile("" : "+s"(p_)); p_; })
    LAS unsigned char* lds = LDSP();
    for (int u = threadIdx.x; u < (LDS_BYTES - LDSCTL_OFF) / 4; u += NWAVES * 64) ((LAS unsigned*)(lds + LDSCTL_OFF))[u] = 0u;
    __syncthreads();
    if (MK_N_LAUNCHES == 1) { KP P = KPARAMS(); (void)xcd_barrier_post((unsigned*)(P->ws + WS_CTL) + CW_BAR, (volatile LAS unsigned*)(lds + MISC_OFF) + 8); }
#define IN(k) (P->ph_lo <= (k) && (k) < P->ph_hi)
#define LANE() (tid_opaque() & 63)
#define WAVE() (__builtin_amdgcn_readfirstlane(tid_opaque() >> 6))

    { KP P = KPARAMS(); if (IN(0)) { p0_prologue(P, lds, VCU(), GRD(), WAVE(), LANE()); __syncthreads(); seam(KPARAMS(), lds, 0); } }

#pragma unroll
    for (int l = 0; l < DEPTH; ++l) {
        const int pb = 1 + 8 * l;
        { KP P = KPARAMS(); LAS unsigned char* lds = LDSP(); if (IN(pb + 0)) { unsigned char* ws = P->ws;
            pg8::Gemm g{(const pg8::bf16_t*)(ws + WS_XB), (const pg8::bf16_t*)(ws + WS_WIN) + (size_t)l * PW * D, T, PW, D};
            pg8::TileOrder S; S.init(T / 256, PW / 256, GRD(), BLK(), nullptr, 0);
            pg8::EpiInProj E{(pg8::bf16_t*)(ws + WS_HB), PW, C2};
            pg8::gemm_phase<pg8::EpiInProj, pg8::TileOrder, PG8_ALIGN, PG8_SP2>(lds + RING_OFF, g, S, E);
            seam(KPARAMS(), lds, pb + 0); } }
        { KP P = KPARAMS(); LAS unsigned char* lds = LDSP(); if (IN(pb + 1)) { att::attn_phase(P, l, lds, VCU(), GRD()); seam(KPARAMS(), lds, pb + 1); } }
        { KP P = KPARAMS(); LAS unsigned char* lds = LDSP(); if (IN(pb + 2)) { unsigned char* ws = P->ws;
            pg8::Gemm g{(const pg8::bf16_t*)(ws + WS_OB), (const pg8::bf16_t*)(ws + WS_WOUT) + (size_t)l * D * D, T, D, D};
            pg8::TileOrder S; S.init(T / 256, D / 256, GRD(), BLK(), nullptr, 0);
            pg8::EpiResF32 E{(float*)(ws + WS_PRE), (l == 0) ? P->in[I_X] : (const float*)(ws + WS_X2F), D, DN_ALPHA};
            pg8::gemm_phase<pg8::EpiResF32, pg8::TileOrder, PG8_ALIGN, PG8_SP2>(lds + RING_OFF, g, S, E);
            seam(KPARAMS(), lds, pb + 2); } }
        { KP P = KPARAMS(); LAS unsigned char* lds = LDSP(); if (IN(pb + 3)) { ln_router_phase(P, l, lds, GRD(), WAVE(), LANE()); seam(KPARAMS(), lds, pb + 3); } }
        { KP P = KPARAMS(); LAS unsigned char* lds = LDSP(); if (IN(pb + 4)) { sort_phase(P, l, lds, VCU(), GRD(), WAVE(), LANE()); __syncthreads(); seam(KPARAMS(), lds, pb + 4); }
          else if (P->ph_hi > pb + 4 && P->ph_lo <= pb + 7 && P->ph_lo > pb + 4) build_offsets(P, l, lds); }
        { KP P = KPARAMS(); LAS unsigned char* lds = LDSP(); if (IN(pb + 5)) { unsigned char* ws = P->ws;
            const int MP = ((const LAS int*)(lds + POFF_OFF))[NE];
            pg8::Gemm g{(const pg8::bf16_t*)(ws + WS_XS), (const pg8::bf16_t*)(ws + WS_WGU) + (size_t)l * NE * 2048 * 1024, MP, 2048, D};
            pg8::TileOrder S; S.init(MP / 256, 8, GRD(), BLK(), lds + TILEE_OFF, (size_t)2048 * 1024 * 2);
            pg8::EpiSwiGLU E{(pg8::bf16_t*)(ws + WS_HID), P->in[I_BGU] + (size_t)l * NE * 2048};
            pg8::gemm_phase<pg8::EpiSwiGLU, pg8::TileOrder, PG8_ALIGN, PG8_SP2>(lds + RING_OFF, g, S, E);
            seam(KPARAMS(), lds, pb + 5); } }
        { KP P = KPARAMS(); LAS unsigned char* lds = LDSP(); if (IN(pb + 6)) { unsigned char* ws = P->ws;
            const int MP = ((const LAS int*)(lds + POFF_OFF))[NE];
            pg8::Gemm g{(const pg8::bf16_t*)(ws + WS_HID), (const pg8::bf16_t*)(ws + WS_WDN) + (size_t)l * NE * 1024 * 1024, MP, 1024, DFF};
            pg8::TileOrder S; S.init(MP / 256, 4, GRD(), BLK(), lds + TILEE_OFF, (size_t)1024 * 1024 * 2);
            pg8::EpiDown E{(pg8::bf16_t*)(ws + WS_Y), P->in[I_BDN] + (size_t)l * NE * 1024};
            pg8::gemm_phase<pg8::EpiDown, pg8::TileOrder, PG8_ALIGN, PG8_SP2>(lds + RING_OFF, g, S, E);
            seam(KPARAMS(), lds, pb + 6); } }
        { KP P = KPARAMS(); LAS unsigned char* lds = LDSP(); if (IN(pb + 7)) { combine_phase(P, l, lds, VCU(), GRD(), WAVE(), LANE()); seam(KPARAMS(), lds, pb + 7); } }
    }
#undef IN
}

extern "C" void kernel_launch(void* const* d_in, const int* in_sizes, int n_in, void* d_out, int out_size, void* d_ws, size_t ws_size, hipStream_t stream) {
    static int grid = 0;
    if (grid == 0) {
        if (n_in != 20 || in_sizes[0] != T * D || out_size != T * D || ws_size < WS_END) { fprintf(stderr, "kernel_launch: unexpected shapes (n_in %d, in0 %d, out %d, ws %zu)\n", n_in, n_in > 0 ? in_sizes[0] : -1, out_size, ws_size); grid = -1; return; }
        int dev = 0, cus = 0, per_cu = 0;
        if (hipGetDevice(&dev) != hipSuccess || hipDeviceGetAttribute(&cus, hipDeviceAttributeMultiprocessorCount, dev) != hipSuccess) { grid = -1; return; }
        if (hipFuncSetAttribute((const void*)mk_fwd, hipFuncAttributeMaxDynamicSharedMemorySize, LDS_BYTES) != hipSuccess) { fprintf(stderr, "kernel_launch: hipFuncSetAttribute failed\n"); grid = -1; return; }
        if (hipOccupancyMaxActiveBlocksPerMultiprocessor(&per_cu, (const void*)mk_fwd, NWAVES * 64, LDS_BYTES) != hipSuccess || per_cu < 1) fprintf(stderr, "kernel_launch: occupancy query reports %d\n", per_cu);
        (void)hipGetLastError();
        grid = cus;
    }
    if (grid < 0) return;
    if (hipMemsetAsync((char*)d_ws + WS_CTL, 0, CTL_ZERO_BYTES, stream) != hipSuccess) return;
    Params p{};
    for (int i = 0; i < 20; ++i) p.in[i] = (const float*)d_in[i];
    p.out = (float*)d_out; p.ws = (unsigned char*)d_ws;
    if (MK_N_LAUNCHES == 1) { p.ph_lo = 0; p.ph_hi = N_PHASES; hipLaunchKernelGGL(mk_fwd, dim3(grid), dim3(NWAVES * 64), LDS_BYTES, stream, p); }
    else { for (int k = 0; k < N_PHASES; ++k) { p.ph_lo = k; p.ph_hi = k + 1; hipLaunchKernelGGL(mk_fwd, dim3(grid), dim3(NWAVES * 64), LDS_BYTES, stream, p); } }
}
```

```cpp
#include <hip/hip_runtime.h>
#include <cstdio>
#include <cstdint>

__device__ __forceinline__ int tid_opaque() { int t = (int)threadIdx.x; asm volatile("" : "+v"(t)); return t; }
__device__ __forceinline__ int sgpr_opaque(int v) { asm volatile("" : "+s"(v)); return v; }
namespace pg8 {
#define PG8_LAS __attribute__((address_space(3)))
typedef unsigned short bf16_t;
typedef short bf16x8 __attribute__((ext_vector_type(8)));
typedef float f32x4 __attribute__((ext_vector_type(4)));
typedef unsigned u32x4 __attribute__((ext_vector_type(4)));
constexpr int BM = 256, BK = 64, HALF = 128, HTB = HALF * BK * 2  , STAGE_BYTES = 8 * HTB, NXCD = 8, WGM = 8;

__host__ __device__ __forceinline__ int lds_byte(int r, int c) { const int st = (r >> 4) * 2 + (c >> 5), rr = r & 15, cc = c & 31, ob = rr * 64 + cc * 2; return st * 1024 + (ob ^ (((ob >> 9) & 1) << 5)); }
__host__ __device__ __forceinline__ void stage_rc(int b, int& R, int& C) { const int st = b / 1024, sb = b % 1024, swz = sb ^ (((sb >> 9) & 1) << 5); R = (st >> 1) * 16 + swz / 64; C = (st & 1) * 32 + (swz % 64) / 2; }
__host__ __device__ __forceinline__ int perm32(int rho) { const int n = rho >> 4, i = rho & 15; return 8 * (i >> 2) + 4 * n + (i & 3); }

struct Unit { int pm, pn, e; size_t boff; };
struct Gemm { const bf16_t* A; const bf16_t* Bt; int M, N, K; };

struct TileOrder {
    int nM, nN, nwg, G, c; const PG8_LAS unsigned char* te; size_t gstride;
    __device__ void init(int nM_, int nN_, int G_, int c_, const PG8_LAS unsigned char* te_, size_t gstride_) { nM = nM_; nN = nN_; nwg = nM * nN; G = G_; c = c_; te = te_; gstride = gstride_; }
    __device__ __forceinline__ bool next(int i, Unit& u) const {
        const long L = (long)i * G + c; if (L >= nwg) return false;
        int wgid = (int)L; { const int q = nwg / NXCD, r = nwg % NXCD, xcd = wgid % NXCD, off = wgid / NXCD; wgid = (xcd < r ? xcd * (q + 1) : r * (q + 1) + (xcd - r) * q) + off; }
        const int nig = WGM * nN, gid = wgid / nig, fm = gid * WGM, gsz = (nM - fm) < WGM ? (nM - fm) : WGM;
        u.pm = fm + ((wgid % nig) % gsz); u.pn = (wgid % nig) / gsz;
        int e = 0; if (te) e = (int)te[u.pm];
        u.e = __builtin_amdgcn_readfirstlane(e); u.boff = (size_t)u.e * gstride; return true;
    }
    __device__ __forceinline__ void a_ready(const Unit&) const {}
    __device__ __forceinline__ void done(const Unit&) const {}
};

typedef float f32x2 __attribute__((ext_vector_type(2))); typedef __bf16 bf16x2v __attribute__((ext_vector_type(2)));
__device__ __forceinline__ unsigned cvt_pk_bf16(float lo, float hi) { f32x2 v = {lo, hi}; bf16x2v b = __builtin_convertvector(v, bf16x2v); return __builtin_bit_cast(unsigned, b); }

struct EpiInProj {
    static constexpr bool PERM = true, AFTER_DRAIN = false;
    bf16_t* O; int ldc; float qscale;
    __device__ __forceinline__ void operator()(const f32x4 (&acc)[2][2][4][2], const Unit& u, int wr, int wc, int fr, int fq) const {
        const int row0 = u.pm * BM + wr * 64 + fr; const int colt = u.pn * BM;
        const float sc = (colt < 512 || (colt >= 1536 && colt < 2048)) ? qscale : 1.f;
        const int col0 = colt + wc * 32 + 8 * fq;
#pragma unroll
        for (int ai = 0; ai < 2; ++ai)
#pragma unroll
            for (int m = 0; m < 4; ++m) { bf16_t* rowp = O + (size_t)(row0 + ai * HALF + m * 16) * ldc + col0;
#pragma unroll
                for (int bj = 0; bj < 2; ++bj) { f32x4 v0 = acc[ai][bj][m][0] * sc, v1 = acc[ai][bj][m][1] * sc;
                    u32x4 w; w.x = cvt_pk_bf16(v0[0], v0[1]); w.y = cvt_pk_bf16(v0[2], v0[3]); w.z = cvt_pk_bf16(v1[0], v1[1]); w.w = cvt_pk_bf16(v1[2], v1[3]);
                    *(u32x4*)(rowp + bj * HALF) = w; } }
    }
};
struct EpiResF32 {
    static constexpr bool PERM = false, AFTER_DRAIN = false;
    float* C; const float* R; int ldc; float alpha;
    __device__ __forceinline__ void operator()(const f32x4 (&acc)[2][2][4][2], const Unit& u, int wr, int wc, int fr, int fq) const {
        const int row0 = u.pm * BM + wr * 64 + fr, col0 = u.pn * BM + wc * 32 + 4 * fq;
#pragma unroll
        for (int ai = 0; ai < 2; ++ai)
#pragma unroll
            for (int m = 0; m < 4; ++m) { const size_t ro = (size_t)(row0 + ai * HALF + m * 16) * ldc + col0;
#pragma unroll
                for (int bj = 0; bj < 2; ++bj)
#pragma unroll
                    for (int n = 0; n < 2; ++n) { const f32x4 rv = *(const f32x4*)(R + ro + bj * HALF + n * 16); *(f32x4*)(C + ro + bj * HALF + n * 16) = acc[ai][bj][m][n] + rv * alpha; } }
    }
};
struct EpiSwiGLU {
    static constexpr bool PERM = true, AFTER_DRAIN = false;
    bf16_t* H; const float* bias;
    __device__ __forceinline__ void operator()(const f32x4 (&acc)[2][2][4][2], const Unit& u, int wr, int wc, int fr, int fq) const {
        const int row0 = u.pm * BM + wr * 64 + fr; const int c0 = u.pn * HALF + wc * 32 + 8 * fq;
        const float* bg = bias + (size_t)u.e * 2048 + c0; const float* bu = bg + 1024;
        f32x4 g0 = *(const f32x4*)bg, g1 = *(const f32x4*)(bg + 4), u0 = *(const f32x4*)bu, u1 = *(const f32x4*)(bu + 4);
#pragma unroll
        for (int ai = 0; ai < 2; ++ai)
#pragma unroll
            for (int m = 0; m < 4; ++m) { bf16_t* rowp = H + (size_t)(row0 + ai * HALF + m * 16) * 1024 + c0;
                float hv[8];
#pragma unroll
                for (int n = 0; n < 2; ++n) { const f32x4 ga = acc[ai][0][m][n] + (n ? g1 : g0), ua = acc[ai][1][m][n] + (n ? u1 : u0);
#pragma unroll
                    for (int i = 0; i < 4; ++i) { const float g = fminf(ga[i], 7.0f), up = fminf(fmaxf(ua[i], -7.0f), 7.0f);
                        const float sg = __builtin_amdgcn_rcpf(1.0f + __builtin_amdgcn_exp2f(g * (-1.702f * 1.4426950408889634f)));
                        hv[4 * n + i] = (up + 1.0f) * (g * sg); } }
                u32x4 w; w.x = cvt_pk_bf16(hv[0], hv[1]); w.y = cvt_pk_bf16(hv[2], hv[3]); w.z = cvt_pk_bf16(hv[4], hv[5]); w.w = cvt_pk_bf16(hv[6], hv[7]);
                *(u32x4*)rowp = w; }
    }
};
struct EpiDown {
    static constexpr bool PERM = true, AFTER_DRAIN = false;
    bf16_t* Y; const float* bias;
    __device__ __forceinline__ void operator()(const f32x4 (&acc)[2][2][4][2], const Unit& u, int wr, int wc, int fr, int fq) const {
        const int row0 = u.pm * BM + wr * 64 + fr; const int col0 = u.pn * BM + wc * 32 + 8 * fq;
        const float* bp = bias + (size_t)u.e * 1024 + col0;
        f32x4 bv[2][2];
#pragma unroll
        for (int bj = 0; bj < 2; ++bj)
#pragma unroll
            for (int n = 0; n < 2; ++n) bv[bj][n] = *(const f32x4*)(bp + bj * HALF + 4 * n);
#pragma unroll
        for (int ai = 0; ai < 2; ++ai)
#pragma unroll
            for (int m = 0; m < 4; ++m) { bf16_t* rowp = Y + (size_t)(row0 + ai * HALF + m * 16) * 1024 + col0;
#pragma unroll
                for (int bj = 0; bj < 2; ++bj) { const f32x4 v0 = acc[ai][bj][m][0] + bv[bj][0], v1 = acc[ai][bj][m][1] + bv[bj][1];
                    u32x4 w; w.x = cvt_pk_bf16(v0[0], v0[1]); w.y = cvt_pk_bf16(v0[2], v0[3]); w.z = cvt_pk_bf16(v1[0], v1[1]); w.w = cvt_pk_bf16(v1[2], v1[3]);
                    *(u32x4*)(rowp + bj * HALF) = w; } }
    }
};

template <class Epi, class Sched, bool ALIGN_EPI = false, bool SP2 = false>
__device__ __forceinline__ void gemm_phase(PG8_LAS unsigned char* lds, const Gemm g, const Sched& S, const Epi& E) {
    const int tid = tid_opaque(), wid = __builtin_amdgcn_readfirstlane(tid >> 6), lane = tid & 63, wr = wid >> 2, wc = wid & 3, fr = lane & 15, fq = lane >> 4;
    const int K = g.K, nt = K / BK;
    unsigned voffA[2], voffB[2];
#pragma unroll
    for (int i = 0; i < 2; ++i) { int R, C; stage_rc(tid * 16 + i * 8192, R, C); const int Rb = Epi::PERM ? ((R & ~31) + perm32(R & 31)) : R;
        voffA[i] = (unsigned)(R * K + C) * 2u; voffB[i] = (unsigned)(Rb * K + C) * 2u; }
    const size_t kstep = (size_t)(BK * 2);
    const size_t hstep = (size_t)HALF * K * 2;
    const size_t tstep = 2 * hstep;
    const unsigned ldsw = (unsigned)wid * 1024u;
    const int aoff = lds_byte(wr * 64 + fr, fq * 8), boff = lds_byte(wc * 32 + fr, fq * 8);
#define PG8_SA(b, h) (((b) * 2 + (h)) * HTB)
#define PG8_SB(b, h) ((4 + (b) * 2 + (h)) * HTB)
#define PG8_STAGE(bufoff, gbase, voff) do { _Pragma("unroll") for (int _i = 0; _i < 2; ++_i) \
        __builtin_amdgcn_global_load_lds((const unsigned*)((const char*)(gbase) + (voff)[_i]), (PG8_LAS unsigned*)(lds + (bufoff) + ldsw + _i * 8192), 16, 0, 0); } while (0)
#define PG8_LDA(dst, b, h) do { _Pragma("unroll") for (int m = 0; m < 4; ++m) _Pragma("unroll") for (int k = 0; k < 2; ++k) dst[m][k] = *(const PG8_LAS bf16x8*)(lds + PG8_SA(b, h) + aoff + m * 2048 + k * 1024); } while (0)
#define PG8_LDB(dst, b, h) do { _Pragma("unroll") for (int n = 0; n < 2; ++n) _Pragma("unroll") for (int k = 0; k < 2; ++k) dst[n][k] = *(const PG8_LAS bf16x8*)(lds + PG8_SB(b, h) + boff + n * 2048 + k * 1024); } while (0)
#define PG8_MMA(ai, bj, At, Bt) do { __builtin_amdgcn_s_setprio(1); _Pragma("unroll") for (int m = 0; m < 4; ++m) _Pragma("unroll") for (int n = 0; n < 2; ++n) _Pragma("unroll") for (int k = 0; k < 2; ++k) \
        acc[ai][bj][m][n] = __builtin_amdgcn_mfma_f32_16x16x32_bf16(Bt[n][k], At[m][k], acc[ai][bj][m][n], 0, 0, 0); __builtin_amdgcn_s_setprio(0); } while (0)
#define PG8_WAIT_V(n) asm volatile("s_waitcnt vmcnt(" #n ")" ::: "memory")
#define PG8_WAIT_L(n) asm volatile("s_waitcnt lgkmcnt(" #n ")" ::: "memory")
#define PG8_BAR __builtin_amdgcn_s_barrier()
#define PG8_SCHED __builtin_amdgcn_sched_barrier(0)
    Unit cur, nxt; int ui = 0;
    if (!S.next(0, cur)) return;
    f32x4 acc[2][2][4][2];
#pragma unroll
    for (int a = 0; a < 2; ++a)
#pragma unroll
        for (int b = 0; b < 2; ++b)
#pragma unroll
            for (int m = 0; m < 4; ++m)
#pragma unroll
                for (int n = 0; n < 2; ++n) acc[a][b][m][n] = (f32x4){0.f, 0.f, 0.f, 0.f};
    bf16x8 At[4][2], B0[2][2], B1[2][2];
    const char* cA = (const char*)g.A + (size_t)cur.pm * tstep; const char* cB = (const char*)g.Bt + cur.boff + (size_t)cur.pn * tstep;
    S.a_ready(cur);
    if constexpr (SP2) {
        PG8_STAGE(PG8_SB(0, 0), cB, voffB); PG8_STAGE(PG8_SB(0, 1), cB + hstep, voffB); PG8_STAGE(PG8_SA(0, 0), cA, voffA); PG8_STAGE(PG8_SA(0, 1), cA + hstep, voffA);
        if (wr == 1) PG8_BAR;
        PG8_WAIT_V(2); PG8_BAR;
        PG8_STAGE(PG8_SB(1, 0), cB + kstep, voffB); PG8_STAGE(PG8_SA(1, 0), cA + kstep, voffA); PG8_STAGE(PG8_SB(1, 1), cB + hstep + kstep, voffB);
        PG8_WAIT_V(6); PG8_BAR;
    } else {
        PG8_STAGE(PG8_SB(0, 0), cB, voffB); PG8_STAGE(PG8_SA(0, 0), cA, voffA); PG8_STAGE(PG8_SB(0, 1), cB + hstep, voffB); PG8_STAGE(PG8_SA(0, 1), cA + hstep, voffA);
        if (wr == 1) PG8_BAR;
        PG8_WAIT_V(4); PG8_BAR;
        PG8_STAGE(PG8_SB(1, 0), cB + kstep, voffB); PG8_STAGE(PG8_SA(1, 0), cA + kstep, voffA); PG8_STAGE(PG8_SB(1, 1), cB + hstep + kstep, voffB);
        PG8_WAIT_V(6); PG8_BAR;
    }
    for (;;) {
        const bool has_next = S.next(ui + 1, nxt);
        const char* nA = has_next ? (const char*)g.A + (size_t)nxt.pm * tstep : cA; const char* nB = has_next ? (const char*)g.Bt + nxt.boff + (size_t)nxt.pn * tstep : cB;
        for (int t = 0; t < nt; t += 2) {
            const bool last = (t == nt - 2);
            const char* a1 = cA + (size_t)(t + 1) * kstep;
            const char* a2 = last ? nA : cA + (size_t)(t + 2) * kstep; const char* b2 = last ? nB : cB + (size_t)(t + 2) * kstep;
            const char* a3 = a2 + kstep; const char* b3 = b2 + kstep;
            if (last && has_next) S.a_ready(nxt);
            if constexpr (SP2) {
            PG8_LDB(B0, 0, 0); PG8_LDB(B1, 0, 1); PG8_SCHED; PG8_LDA(At, 0, 0); PG8_STAGE(PG8_SA(1, 1), a1 + hstep, voffA);
            PG8_WAIT_V(8); PG8_WAIT_L(0); PG8_BAR; PG8_MMA(0, 0, At, B0); PG8_MMA(0, 1, At, B1); PG8_BAR; PG8_SCHED;
            PG8_LDA(At, 0, 1); PG8_STAGE(PG8_SB(0, 0), b2, voffB); PG8_STAGE(PG8_SB(0, 1), b2 + hstep, voffB); PG8_STAGE(PG8_SA(0, 0), a2, voffA);
            PG8_WAIT_V(8); PG8_WAIT_L(0); PG8_BAR; PG8_MMA(1, 0, At, B0); PG8_MMA(1, 1, At, B1); PG8_BAR; PG8_SCHED;
            PG8_LDB(B0, 1, 0); PG8_LDB(B1, 1, 1); PG8_SCHED; PG8_LDA(At, 1, 0); PG8_STAGE(PG8_SA(0, 1), a2 + hstep, voffA);
            PG8_WAIT_V(8); PG8_WAIT_L(0); PG8_BAR; PG8_MMA(0, 0, At, B0); PG8_MMA(0, 1, At, B1); PG8_BAR; PG8_SCHED;
            PG8_LDA(At, 1, 1); PG8_STAGE(PG8_SB(1, 0), b3, voffB); PG8_STAGE(PG8_SB(1, 1), b3 + hstep, voffB); PG8_STAGE(PG8_SA(1, 0), a3, voffA);
            PG8_WAIT_V(8); PG8_WAIT_L(0); PG8_BAR; PG8_MMA(1, 0, At, B0); PG8_MMA(1, 1, At, B1); PG8_BAR; PG8_SCHED;
            } else {
            PG8_LDB(B0, 0, 0); PG8_SCHED; PG8_LDA(At, 0, 0); PG8_STAGE(PG8_SA(1, 1), a1 + hstep, voffA);
            PG8_WAIT_L(8); PG8_BAR; PG8_WAIT_L(0); PG8_MMA(0, 0, At, B0); PG8_BAR; PG8_SCHED;
            PG8_LDB(B1, 0, 1); PG8_STAGE(PG8_SB(0, 0), b2, voffB);
            PG8_BAR; PG8_WAIT_L(0); PG8_MMA(0, 1, At, B1); PG8_BAR;
            PG8_LDA(At, 0, 1); PG8_STAGE(PG8_SA(0, 0), a2, voffA);
            PG8_BAR; PG8_WAIT_L(0); PG8_MMA(1, 0, At, B0); PG8_BAR; PG8_SCHED;
            PG8_STAGE(PG8_SB(0, 1), b2 + hstep, voffB);
            PG8_WAIT_V(6); PG8_BAR; PG8_MMA(1, 1, At, B1); PG8_BAR;
            PG8_LDB(B0, 1, 0); PG8_SCHED; PG8_LDA(At, 1, 0); PG8_STAGE(PG8_SA(0, 1), a2 + hstep, voffA);
            PG8_WAIT_L(8); PG8_BAR; PG8_WAIT_L(0); PG8_MMA(0, 0, At, B0); PG8_BAR; PG8_SCHED;
            PG8_LDB(B1, 1, 1); PG8_STAGE(PG8_SB(1, 0), b3, voffB);
            PG8_BAR; PG8_WAIT_L(0); PG8_MMA(0, 1, At, B1); PG8_BAR;
            PG8_LDA(At, 1, 1); PG8_STAGE(PG8_SA(1, 0), a3, voffA);
            PG8_BAR; PG8_WAIT_L(0); PG8_MMA(1, 0, At, B0); PG8_BAR; PG8_SCHED;
            PG8_STAGE(PG8_SB(1, 1), b3 + hstep, voffB);
            PG8_WAIT_V(6); PG8_BAR; PG8_MMA(1, 1, At, B1); PG8_BAR;
            }
        }
        if constexpr (ALIGN_EPI) { if (wr == 0) PG8_BAR; }
        if constexpr (!Epi::AFTER_DRAIN) { E(acc, cur, wr, wc, fr, fq); S.done(cur); }
        if (!has_next) break;
#pragma unroll
        for (int a = 0; a < 2; ++a)
#pragma unroll
            for (int b = 0; b < 2; ++b)
#pragma unroll
                for (int m = 0; m < 4; ++m)
#pragma unroll
                    for (int n = 0; n < 2; ++n) acc[a][b][m][n] = (f32x4){0.f, 0.f, 0.f, 0.f};
        cur = nxt; cA = nA; cB = nB; ++ui;
        if constexpr (ALIGN_EPI) { if (wr == 1) PG8_BAR; }
    }
    PG8_WAIT_V(0);
    if constexpr (!ALIGN_EPI) { if (wr == 0) PG8_BAR; }
    PG8_BAR;
    if constexpr (Epi::AFTER_DRAIN) { E.fused(acc, cur, wr, wc, fr, fq, lds, wid, lane); S.done(cur); }
#undef PG8_SA
#undef PG8_SB
#undef PG8_STAGE
#undef PG8_LDA
#undef PG8_LDB
#undef PG8_MMA
#undef PG8_WAIT_V
#undef PG8_WAIT_L
#undef PG8_BAR
#undef PG8_SCHED
}
}

#ifndef PG8_SP2
#define PG8_SP2 true
#endif
#ifndef PG8_ALIGN
#define PG8_ALIGN true
#endif
#ifndef MK_N_LAUNCHES
#define MK_N_LAUNCHES 1
#endif

constexpr int NWAVES = 8;
constexpr int NB = 4, SEQ = 8192, T = NB * SEQ, D = 1024, PW = 3072, NE = 32, TOPK = 4, DFF = 1024, DEPTH = 2;
constexpr int GRIDW = 64, GROWS = SEQ / GRIDW;
constexpr int MPAD_MAX = T * TOPK + NE * 256;
constexpr float LN_EPS = 1e-5f, DA_EPS = 1e-5f;
constexpr float LOG2E = 1.4426950408889634f;
constexpr float C2 = 0.125f * LOG2E;
constexpr float DN_ALPHA = 1.4142135623730951f;
constexpr int N_PHASES = 1 + 8 * DEPTH;

constexpr size_t MiB = 1u << 20;
constexpr size_t WS_CTL = 0, CTL_ZERO_BYTES = 1 * MiB;
constexpr size_t WS_WIN = 2 * MiB, WS_WOUT = 14 * MiB, WS_WGU = 18 * MiB, WS_WDN = 274 * MiB;
constexpr size_t WS_XB = 402 * MiB;
constexpr size_t WS_RA = 466 * MiB;
constexpr size_t WS_HB = WS_RA, WS_OB = WS_RA + 192 * MiB, WS_PRE = WS_RA + 256 * MiB, WS_XS = WS_RA, WS_Y = WS_RA;
constexpr size_t WS_X1F = 850 * MiB, WS_X1B = 978 * MiB, WS_HID = 1042 * MiB, WS_X2F = 1314 * MiB;
constexpr size_t WS_TKE = 1442 * MiB, WS_TKG = WS_TKE + 512 * 1024, WS_SLOT = 1443 * MiB, WS_TOKL = 1444 * MiB, WS_END = 1448 * MiB;
static_assert((size_t)MPAD_MAX * 1024 * 2 <= 272 * MiB, "XS/HID/Y size");
constexpr int CW_BAR = 4096;
constexpr int CW_CNT = 65536;

constexpr int RING_OFF = 0, RING_BYTES = 131072;
constexpr int LDSCTL_OFF = RING_BYTES;
constexpr int MISC_OFF = LDSCTL_OFF;
constexpr int POFF_OFF = LDSCTL_OFF + 256;
constexpr int ECNT_OFF = LDSCTL_OFF + 512;
constexpr int TILEE_OFF = LDSCTL_OFF + 768;
constexpr int BTAB_OFF = LDSCTL_OFF + 2048;
constexpr int RPB_OFF = LDSCTL_OFF + 6400;
constexpr int WSF_OFF = LDSCTL_OFF + 8448;
constexpr int SEL_OFF = LDSCTL_OFF + 10752;
constexpr int LGS_OFF = LDSCTL_OFF + 12800;
constexpr int LDS_BYTES = 147456;
static_assert(LGS_OFF + 8 * 128 <= LDS_BYTES, "LDS map");

#define GAS __attribute__((address_space(1)))
#define LAS __attribute__((address_space(3)))
typedef unsigned short bf16;
typedef unsigned v4u __attribute__((ext_vector_type(4)));
typedef unsigned v2u __attribute__((ext_vector_type(2)));
typedef float f32x4 __attribute__((ext_vector_type(4)));
typedef float f32x16 __attribute__((ext_vector_type(16)));
typedef short bf16x8 __attribute__((ext_vector_type(8)));
typedef short s16x4 __attribute__((ext_vector_type(4)));
typedef GAS unsigned gu32;
#define RLX_AGENT __ATOMIC_RELAXED, __HIP_MEMORY_SCOPE_AGENT
#define LDS_WAIT() asm volatile("s_waitcnt lgkmcnt(0)" ::: "memory")
#define VM_WAIT() asm volatile("s_waitcnt vmcnt(0)" ::: "memory")
__device__ __forceinline__ unsigned pk2(float lo, float hi) { return pg8::cvt_pk_bf16(lo, hi); }
__device__ __forceinline__ float bf_lo(unsigned w) { return __uint_as_float(w << 16); }
__device__ __forceinline__ float bf_hi(unsigned w) { return __uint_as_float(w & 0xffff0000u); }
__device__ __forceinline__ float wave_sum(float v) {
#pragma unroll
    for (int o = 1; o < 64; o <<= 1) v += __shfl_xor(v, o);
    return v;
}

#define GRD() sgpr_opaque((int)gridDim.x)
#define BLK() sgpr_opaque((int)blockIdx.x)
__device__ __forceinline__ int vcu_of(int G, int bx) { return (G % 8 == 0) ? (bx % 8) * (G / 8) + bx / 8 : bx; }
#define VCU() vcu_of(GRD(), BLK())
#define XB_TMO      128
#define XB_XCNT(j)  (256  + 64 * (j))
#define XB_XSUB(j)  (1280 + 64 * (j))
#define XB_XGEN(j)  (2304 + 64 * (j))
#define XB_TOP      3328
#define XB_TOPGEN   3392
#define XCD_BAR_WORDS 3456
#define XB_SPIN_CAP (1u << 18)

__device__ __forceinline__ unsigned xb_ld(unsigned* p)              { return __hip_atomic_load(p, __ATOMIC_RELAXED, __HIP_MEMORY_SCOPE_AGENT); }
__device__ __forceinline__ unsigned xb_add(unsigned* p, unsigned v) { return __hip_atomic_fetch_add(p, v, __ATOMIC_RELAXED, __HIP_MEMORY_SCOPE_AGENT); }
__device__ __forceinline__ unsigned xb_xcc_id() { return (unsigned)__builtin_amdgcn_s_getreg((3 << 11) | 20) & 0xFu; }
#define XB_SPIN(cond, bar) do { unsigned _sp = 0; while (cond) { __builtin_amdgcn_s_sleep(1); \
    if ((++_sp & 255u) == 0u) { if (xb_ld(&(bar)[XB_TMO])) break; if (_sp > XB_SPIN_CAP) { atomicAdd(&(bar)[XB_TMO], 1u); break; } } } } while (0)

struct XcdBarrier { unsigned* bar; unsigned x; volatile LAS unsigned* st; };

__device__ __forceinline__ XcdBarrier xcd_barrier_post(unsigned* bar, volatile LAS unsigned* st) {
    XcdBarrier b; b.bar = bar; b.x = xb_xcc_id(); b.st = st;
    if (threadIdx.x == 0) (void)xb_add(&bar[XB_XCNT(b.x)], 1u);
    return b;
}
__device__ __forceinline__ void xcd_barrier_complete(unsigned* bar, unsigned x, unsigned& nloc, unsigned& nx) {
    const unsigned G = gridDim.x * gridDim.y * gridDim.z;
    unsigned sum, cnt, mine, sp = 0u;
    for (;;) {
        sum = 0u; cnt = 0u; mine = 0u;
#pragma unroll
        for (unsigned j = 0; j < 16; ++j) { const unsigned c = xb_ld(&bar[XB_XCNT(j)]); sum += c; cnt += (c > 0u) ? 1u : 0u; mine = (j == x) ? c : mine; }
        if (sum == G) break;
        __builtin_amdgcn_s_sleep(1);
        if ((++sp & 255u) == 0u) { if (xb_ld(&bar[XB_TMO])) break; if (sp > XB_SPIN_CAP) { atomicAdd(&bar[XB_TMO], 1u); break; } }
    }
    nloc = mine > 0u ? mine : 1u; nx = cnt > 0u ? cnt : 1u;
}
__device__ __forceinline__ void xcd_barrier(const XcdBarrier& b) {
    asm volatile("s_waitcnt vmcnt(0)" ::: "memory");
    __syncthreads();
    if (threadIdx.x == 0) {
        unsigned* bar = b.bar;
        __builtin_amdgcn_s_waitcnt(0);
        unsigned nloc = b.st[0], nx = b.st[1];
        if (nloc == 0u) { xcd_barrier_complete(bar, b.x, nloc, nx); b.st[0] = nloc; b.st[1] = nx; }
        const unsigned old = xb_add(&bar[XB_XSUB(b.x)], 1u);
        const unsigned gen = old / nloc;
        if (old + 1u == (gen + 1u) * nloc) {
            __builtin_amdgcn_fence(__ATOMIC_RELEASE, "agent");
            asm volatile("s_waitcnt vmcnt(0)" ::: "memory");
            const unsigned og = xb_add(&bar[XB_TOP], 1u);
            const unsigned tg = og / nx;
            if (og + 1u == (tg + 1u) * nx) xb_add(&bar[XB_TOPGEN], 1u);
            else XB_SPIN(xb_ld(&bar[XB_TOPGEN]) == tg, bar);
            __builtin_amdgcn_fence(__ATOMIC_ACQUIRE, "agent");
            xb_add(&bar[XB_XGEN(b.x)], 1u);
            asm volatile("s_waitcnt vmcnt(0)" ::: "memory");
        } else {
            XB_SPIN(xb_ld(&bar[XB_XGEN(b.x)]) == gen, bar);
            __builtin_amdgcn_fence(__ATOMIC_ACQUIRE, "agent");
            asm volatile("s_waitcnt vmcnt(0)" ::: "memory");
        }
    }
    __syncthreads();
}

struct Params { const float* in[20]; float* out; unsigned char* ws; int ph_lo, ph_hi; };
typedef const __attribute__((address_space(4))) Params* KP;
enum { I_X = 0, I_WIN, I_WOUT, I_LQ1, I_LK1, I_LQ2, I_LK2, I_SUBLN, I_T5, I_RPB, I_LN1G, I_LN1B, I_RW, I_RB, I_WGU, I_BGU, I_WDN, I_BDN, I_LN2G, I_LN2B };

__device__ __forceinline__ void transpose_item(const float* Wsrc  , size_t ldw, bf16* WTdst  , int K, LAS unsigned* scr, int lane) {
    const int l31 = lane & 31, kh = lane >> 5;
    const float* src = Wsrc + (size_t)(2 * kh) * ldw + 4 * l31;
#pragma unroll
    for (int half = 0; half < 2; ++half) {
        f32x4 v0[8], v1[8];
#pragma unroll
        for (int i = 0; i < 8; ++i) { const float* p = src + (size_t)(4 * (8 * half + i)) * ldw; v0[i] = *(const f32x4*)p; v1[i] = *(const f32x4*)(p + ldw); }
#pragma unroll
        for (int i = 0; i < 8; ++i) { const int kp = 2 * (8 * half + i) + kh;
            const int col = kp ^ ((l31 & 7) << 2);
#pragma unroll
            for (int j = 0; j < 4; ++j) scr[(4 * l31 + j) * 32 + col] = pk2(v0[i][j], v1[i][j]); }
    }
    LDS_WAIT(); asm volatile("" ::: "memory");
#pragma unroll
    for (int i2 = 0; i2 < 16; ++i2) { const int n = 8 * i2 + (lane >> 3), c = lane & 7, cs = c ^ ((n >> 2) & 7);
        const v4u o = *(const LAS v4u*)(scr + n * 32 + 4 * cs);
        *(v4u*)(WTdst + (size_t)n * K + 8 * c) = o; }
    LDS_WAIT(); asm volatile("" ::: "memory");
}
__device__ __forceinline__ void p0_prologue(KP P, LAS unsigned char* lds, int vcu, int G, int wave, int lane) {
    LAS unsigned* scr = (LAS unsigned*)(lds + RING_OFF + wave * 16384);
    const int gw = vcu * NWAVES + wave, NGW = G * NWAVES;
    unsigned char* ws = P->ws;
    constexpr int I_GU = 2 * 32 * 256, I_DN = 2 * 32 * 128, I_IN = 2 * 384, I_OUT = 2 * 128, NITEMS = I_GU + I_DN + I_IN + I_OUT;
    for (int it = gw; it < NITEMS; it += NGW) {
        int r = it;
        if (r < I_GU) { const int le = r >> 8, kt = (r >> 4) & 15, nt = r & 15;
            const float* W = P->in[I_WGU] + (size_t)le * 1024 * 2048;
            const int n0 = nt * 128; const int orow = (n0 < 1024) ? (256 * (n0 >> 7)) : (256 * ((n0 - 1024) >> 7) + 128);
            bf16* WT = (bf16*)(ws + WS_WGU) + (size_t)le * 2048 * 1024;
            transpose_item(W + (size_t)(kt * 64) * 2048 + n0, 2048, WT + (size_t)orow * 1024 + kt * 64, 1024, scr, lane); continue; }
        r -= I_GU;
        if (r < I_DN) { const int le = r >> 7, kt = (r >> 3) & 15, nt = r & 7;
            const float* W = P->in[I_WDN] + (size_t)le * 1024 * 1024;
            bf16* WT = (bf16*)(ws + WS_WDN) + (size_t)le * 1024 * 1024;
            transpose_item(W + (size_t)(kt * 64) * 1024 + nt * 128, 1024, WT + (size_t)(nt * 128) * 1024 + kt * 64, 1024, scr, lane); continue; }
        r -= I_DN;
        if (r < I_IN) { const int l = r / 384, q = r % 384, kt = q / 24, nt = q % 24;
            const float* W = P->in[I_WIN] + (size_t)l * 1024 * 3072;
            bf16* WT = (bf16*)(ws + WS_WIN) + (size_t)l * 3072 * 1024;
            transpose_item(W + (size_t)(kt * 64) * 3072 + nt * 128, 3072, WT + (size_t)(nt * 128) * 1024 + kt * 64, 1024, scr, lane); continue; }
        r -= I_IN;
        { const int l = r >> 7, kt = (r >> 3) & 15, nt = r & 7;
            const float* W = P->in[I_WOUT] + (size_t)l * 1024 * 1024;
            bf16* WT = (bf16*)(ws + WS_WOUT) + (size_t)l * 1024 * 1024;
            transpose_item(W + (size_t)(kt * 64) * 1024 + nt * 128, 1024, WT + (size_t)(nt * 128) * 1024 + kt * 64, 1024, scr, lane); }
    }
    const f32x4* x4 = (const f32x4*)P->in[I_X]; v4u* xb = (v4u*)(ws + WS_XB);
    const size_t nchunk = (size_t)T * D / 8, gt = (size_t)gw * 64 + lane, ngt = (size_t)NGW * 64;
    for (size_t i = gt; i < nchunk; i += ngt) { const f32x4 a = x4[2 * i], b = x4[2 * i + 1]; v4u o; o.x = pk2(a[0], a[1]); o.y = pk2(a[2], a[3]); o.z = pk2(b[0], b[1]); o.w = pk2(b[2], b[3]); xb[i] = o; }
}

namespace att {
__device__ __forceinline__ int crow(int r, int hi) { return (r & 3) + 8 * (r >> 2) + 4 * hi; }
__device__ __forceinline__ void glds16(const void* gsrc, LAS unsigned char* lds_dst) {
    __builtin_amdgcn_global_load_lds((const unsigned*)gsrc, (LAS unsigned*)lds_dst, 16, 0, 0); }
typedef short v4i16_t __attribute__((ext_vector_type(4)));
__device__ __forceinline__ s16x4 vtr(const LAS char* p) { return __builtin_bit_cast(s16x4, __builtin_amdgcn_ds_read_tr16_b64_v4i16((LAS v4i16_t*)p)); }
#define ATT_WAIT_BAR() asm volatile("s_waitcnt vmcnt(0) lgkmcnt(0)\n\ts_barrier" ::: "memory")
constexpr float THR = 8.0f;

__device__ __forceinline__ void qkt(f32x16& p0, f32x16& p1, const LAS char* kb, const bf16x8 (&qr)[4], float ci) {
    f32x16 c;
#pragma unroll
    for (int r = 0; r < 16; ++r) c[r] = ci;
#pragma unroll
    for (int d0 = 0; d0 < 4; ++d0) {
        const bf16x8 b0 = *(const LAS bf16x8*)(kb + d0 * 2048);
        const bf16x8 b1 = *(const LAS bf16x8*)(kb + d0 * 2048 + 512);
        if (d0 == 0) { p0 = __builtin_amdgcn_mfma_f32_32x32x16_bf16(b0, qr[0], c, 0, 0, 0); p1 = __builtin_amdgcn_mfma_f32_32x32x16_bf16(b1, qr[0], c, 0, 0, 0); }
        else { p0 = __builtin_amdgcn_mfma_f32_32x32x16_bf16(b0, qr[d0], p0, 0, 0, 0); p1 = __builtin_amdgcn_mfma_f32_32x32x16_bf16(b1, qr[d0], p1, 0, 0, 0); }
    }
}
template <int NEB>
__device__ __forceinline__ void softmax_pv(f32x16& p0, f32x16& p1, float& mhat, float& lsum, f32x16 (&o)[NEB], bool force, volatile LAS float* wsf, const LAS char* vb, int r32, int hi) {
    float rm = fmaxf(p0[0], p1[0]);
#pragma unroll
    for (int r = 1; r < 16; ++r) rm = fmaxf(rm, fmaxf(p0[r], p1[r]));
    { auto rr = __builtin_amdgcn_permlane32_swap(__float_as_uint(rm), __float_as_uint(rm), false, false); rm = fmaxf(__uint_as_float(rr[0]), __uint_as_float(rr[1])); }
    if (force || __any(rm > THR)) {
        const float dl = force ? rm : fmaxf(rm, 0.f);
        mhat += dl;
#pragma unroll
        for (int r = 0; r < 16; ++r) { p0[r] -= dl; p1[r] -= dl; }
        if (!force) {
            const float f = __builtin_amdgcn_exp2f(-dl);
            lsum *= f;
            if (hi == 0) wsf[r32] = f;
            LDS_WAIT();
#pragma unroll
            for (int r = 0; r < 16; ++r) { const float fr = wsf[crow(r, hi)];
#pragma unroll
                for (int d = 0; d < NEB; ++d) o[d][r] *= fr; }
        }
    }
    float s = 0.f;
#pragma unroll
    for (int r = 0; r < 16; ++r) { p0[r] = __builtin_amdgcn_exp2f(p0[r]); p1[r] = __builtin_amdgcn_exp2f(p1[r]); s += p0[r] + p1[r]; }
    lsum += s;
    v4u pw[4];
    pw[0] = (v4u){pk2(p0[0], p0[1]), pk2(p0[2], p0[3]), pk2(p0[4], p0[5]), pk2(p0[6], p0[7])};
    pw[1] = (v4u){pk2(p0[8], p0[9]), pk2(p0[10], p0[11]), pk2(p0[12], p0[13]), pk2(p0[14], p0[15])};
    pw[2] = (v4u){pk2(p1[0], p1[1]), pk2(p1[2], p1[3]), pk2(p1[4], p1[5]), pk2(p1[6], p1[7])};
    pw[3] = (v4u){pk2(p1[8], p1[9]), pk2(p1[10], p1[11]), pk2(p1[12], p1[13]), pk2(p1[14], p1[15])};
#pragma unroll
    for (int d0 = 0; d0 < NEB; ++d0)
#pragma unroll
        for (int ks = 0; ks < 4; ++ks) {
            const s16x4 lo = vtr(vb + d0 * 4096 + ks * 1024), hh = vtr(vb + d0 * 4096 + ks * 1024 + 512);
            const bf16x8 vf = (bf16x8){lo[0], lo[1], lo[2], lo[3], hh[0], hh[1], hh[2], hh[3]};
            o[d0] = __builtin_amdgcn_mfma_f32_32x32x16_bf16(__builtin_bit_cast(bf16x8, pw[ks]), vf, o[d0], 0, 0, 0);
        }
}

__device__ __forceinline__ void glds16a(const void* sbase, unsigned voff, unsigned lds_dst) { unsigned keep;
    asm volatile("s_mov_b32 %0, m0\n\ts_mov_b32 m0, %3\n\ts_nop 0\n\tglobal_load_lds_dwordx4 %1, %2\n\ts_mov_b32 m0, %0" : "=&s"(keep) : "v"(voff), "s"(sbase), "s"(lds_dst) : "memory"); }
#define DA_WAIT_BAR(N) asm volatile("s_waitcnt vmcnt(" #N ") lgkmcnt(0)\n\ts_barrier" ::: "memory")
#define SBAR() __builtin_amdgcn_sched_barrier(0)
constexpr int DA_K1 = 0, DA_K2 = 24576, DA_V = 49152, DA_KS = 8192, DA_VS = 16384;
__device__ __forceinline__ void da_unit(int b, int h, int qb, const bf16* HB, bf16* OB, LAS unsigned char* lds, float lam, float out_scale, const float* subln_g) {
    const int tid = tid_opaque(), lane = tid & 63, r32 = lane & 31, hi = lane >> 5; const int wid = __builtin_amdgcn_readfirstlane(tid >> 6);
    const int br = wid >> 2, qw = wid & 3;
    const size_t rowbase = (size_t)b * SEQ; const int q0 = qb * 128, q0w = q0 + qw * 32;
    const bf16* Qw = HB + (rowbase + q0w) * PW + br * 256 + h * 64;
    const bf16* Kh = HB + rowbase * PW + 512 + br * 256 + h * 64;
    const bf16* Vh = HB + rowbase * PW + 1024 + h * 128;
    const unsigned lds0 = (unsigned)(uintptr_t)lds;
    volatile LAS float* wsf = (volatile LAS float*)(lds + WSF_OFF) + wid * 64;
    const LAS float* bt = (const LAS float*)(lds + BTAB_OFF) + h * 260;
    const int vpi0 = 2 * wid;
    const unsigned kvoff = (unsigned)(lane * PW + (2 * qw) * 8) * 2u;
    const unsigned vvoff = (unsigned)((16 * (vpi0 & 3) + (lane >> 2)) * PW + 32 * (vpi0 >> 2) + (lane & 3) * 8) * 2u;
    const unsigned kdst = lds0 + (br ? DA_K2 : DA_K1) + (2 * qw) * 1024, vdst = lds0 + DA_V + vpi0 * 1024;
#define SGP(p) ((const char*)(((unsigned long long)(unsigned)__builtin_amdgcn_readfirstlane((int)((unsigned long long)(p) >> 32)) << 32) | (unsigned)__builtin_amdgcn_readfirstlane((int)(unsigned long long)(p))))
#define DMA_K(t, slot) do { const char* kb_ = SGP((const char*)Kh + (size_t)(t) * 64 * PW * 2); glds16a(kb_, kvoff, (unsigned)__builtin_amdgcn_readfirstlane(kdst + (slot) * DA_KS)); glds16a(kb_ + 16, kvoff, (unsigned)__builtin_amdgcn_readfirstlane(kdst + (slot) * DA_KS + 1024)); } while (0)
#define DMA_V(t, slot) do { const char* vb_ = SGP((const char*)Vh + (size_t)(t) * 64 * PW * 2); glds16a(vb_, vvoff, (unsigned)__builtin_amdgcn_readfirstlane(vdst + (slot) * DA_VS)); glds16a(vb_ + 16 * PW * 2, vvoff, (unsigned)__builtin_amdgcn_readfirstlane(vdst + (slot) * DA_VS + 1024)); } while (0)
    const LAS char* kp0 = (const LAS char*)lds + (br ? DA_K2 : DA_K1) + hi * 1024 + r32 * 16;
    const LAS char* vp0 = (const LAS char*)lds + DA_V + ((lane >> 4) & 1) * 32 + (lane & 3) * 8 + (4 * hi + ((lane & 15) >> 2)) * 64;
    constexpr int NT = SEQ / 64;
    DMA_K(0, 0); DMA_V(0, 0); DMA_K(1, 1);
    bf16x8 qr[4];
#pragma unroll
    for (int d0 = 0; d0 < 4; ++d0) qr[d0] = *(const bf16x8*)(Qw + (size_t)r32 * PW + d0 * 16 + hi * 8);
    float mhat = 0.f, l_reg = 0.f; f32x16 o[4];
#pragma unroll
    for (int d = 0; d < 4; ++d)
#pragma unroll
        for (int r = 0; r < 16; ++r) o[d][r] = 0.f;
    const float bneg = __int_as_float(__builtin_amdgcn_readfirstlane(__float_as_int(bt[0]))), bpos = __int_as_float(__builtin_amdgcn_readfirstlane(__float_as_int(bt[256])));
#define TCLASS(t) ((64 * (t) + 63 - q0w <= -128) ? 0 : ((64 * (t) - (q0w + 31) >= 128) ? 2 : 1))
#define TBIAS(c) ((c) == 0 ? bneg : ((c) == 2 ? bpos : 0.f))
    f32x16 cinit;
#define SET_CINIT(v) do { const float v_ = (v); _Pragma("unroll") for (int r = 0; r < 16; ++r) cinit[r] = v_; asm volatile("" : "+v"(cinit)); } while (0)
#define DIAG_BIAS(C0, C1, t) do { const int base_ = 64 * (t) - q0w - r32 + 4 * hi; \
        _Pragma("unroll") for (int r = 0; r < 16; ++r) { const int rel_ = base_ + (r & 3) + 8 * (r >> 2); \
            const int i0_ = min(max(rel_, -128), 128) + 128, i1_ = min(max(rel_ + 32, -128), 128) + 128; C0[r] += bt[i0_]; C1[r] += bt[i1_]; if ((r & 3) == 3) SBAR(); } } while (0)
    int cls = TCLASS(0);
    SET_CINIT(TBIAS(cls));
    DMA_K(2, 2);
    DA_WAIT_BAR(6);
    f32x16 pA0, pA1, pB0, pB1;
    bool resc = false;
    qkt(pA0, pA1, kp0, qr, TBIAS(cls));
    if (cls == 1) DIAG_BIAS(pA0, pA1, 0);
    { float rm = fmaxf(pA0[0], pA1[0]);
#pragma unroll
      for (int r = 1; r < 16; ++r) rm = fmaxf(rm, fmaxf(pA0[r], pA1[r]));
      { auto rr = __builtin_amdgcn_permlane32_swap(__float_as_uint(rm), __float_as_uint(rm), false, false); rm = fmaxf(__uint_as_float(rr[0]), __uint_as_float(rr[1])); }
      mhat = rm;
#pragma unroll
      for (int r = 0; r < 16; ++r) { pA0[r] = __builtin_amdgcn_exp2f(pA0[r] - rm); pA1[r] = __builtin_amdgcn_exp2f(pA1[r] - rm); } }
    SET_CINIT(TBIAS(cls) - mhat);
    DA_WAIT_BAR(0);
    DMA_K(3, 0); DMA_V(1, 1);
    bf16x8 kf[8];
#define KLOAD2(kp, j) do { kf[2 * (j)] = *(const LAS bf16x8*)((kp) + (j) * 2048); kf[2 * (j) + 1] = *(const LAS bf16x8*)((kp) + (j) * 2048 + 512); } while (0)
    KLOAD2(kp0 + DA_KS, 0); KLOAD2(kp0 + DA_KS, 1); KLOAD2(kp0 + DA_KS, 2); KLOAD2(kp0 + DA_KS, 3);
    DA_WAIT_BAR(4);
    s16x4 vlo[4], vhi[4]; v4u pw0, pw1, pw2, pw3;
#define PKW(P, B) pk2(P[B], P[(B) + 1])
#define PAF(k) __builtin_bit_cast(bf16x8, pw##k)
#define VFR(i) ((bf16x8){vlo[i][0], vlo[i][1], vlo[i][2], vlo[i][3], vhi[i][0], vhi[i][1], vhi[i][2], vhi[i][3]})
#define PIN(x) asm volatile("" : "+v"(x))
#define EX(v) __builtin_amdgcn_exp2f(v)
#define VRD(f) do { vlo[(f) & 3] = vtr(vp_ + (((f) & 3) * 4096 + ((f) >> 2) * 1024)); vhi[(f) & 3] = vtr(vp_ + (((f) & 3) * 4096 + ((f) >> 2) * 1024 + 512)); } while (0)
#define GAPA(MF, A0, A1, A2, A3, W0, W1, PW) do { MF; sacc += A0; sacc += A1; sacc += A2; sacc += A3; PIN(sacc); W0; W1; PIN(PW); SBAR(); } while (0)
#define PVM(f, X, B) do { o[(f) & 3] = __builtin_amdgcn_mfma_f32_32x32x16_bf16(((f) >> 2) == 0 ? PAF(0) : ((f) >> 2) == 1 ? PAF(1) : ((f) >> 2) == 2 ? PAF(2) : PAF(3), VFR((f) & 3), o[(f) & 3], 0, 0, 0); \
        X[B] = EX(X[B]); X[(B) + 1] = EX(X[(B) + 1]); PIN(X); } while (0)
#define STEP(C0, C1, P0, P1, t, GK, GV, GL) do { SBAR(); \
    const LAS char* vp_ = vp0 + v_prev * DA_VS; const LAS char* kn_ = kp0 + k_next * DA_KS; \
    const int ncls_ = TCLASS(t); if (ncls_ != cls) { cls = ncls_; SET_CINIT(TBIAS(cls) - mhat); } \
    float sacc = (P0[0] + P0[1]); \
    GAPA(C0 = __builtin_amdgcn_mfma_f32_32x32x16_bf16(kf[0], qr[0], cinit, 0, 0, 0), P0[2], P0[3], P0[4], P0[5],     pw0[0] = PKW(P0, 0),  pw0[1] = PKW(P0, 2),  pw0); \
    GAPA(C1 = __builtin_amdgcn_mfma_f32_32x32x16_bf16(kf[1], qr[0], cinit, 0, 0, 0), P0[6], P0[7], P0[8], P0[9],     pw0[2] = PKW(P0, 4),  pw0[3] = PKW(P0, 6),  pw0); \
    GAPA(C0 = __builtin_amdgcn_mfma_f32_32x32x16_bf16(kf[2], qr[1], C0, 0, 0, 0),    P0[10], P0[11], P0[12], P0[13], pw1[0] = PKW(P0, 8),  pw1[1] = PKW(P0, 10), pw1); \
    GAPA(C1 = __builtin_amdgcn_mfma_f32_32x32x16_bf16(kf[3], qr[1], C1, 0, 0, 0),    P0[14], P0[15], P1[0], P1[1],   pw1[2] = PKW(P0, 12), pw1[3] = PKW(P0, 14), pw1); \
    VRD(0); SBAR(); GAPA(C0 = __builtin_amdgcn_mfma_f32_32x32x16_bf16(kf[4], qr[2], C0, 0, 0, 0),    P1[2], P1[3], P1[4], P1[5],     pw2[0] = PKW(P1, 0),  pw2[1] = PKW(P1, 2),  pw2); \
    VRD(1); SBAR(); GAPA(C1 = __builtin_amdgcn_mfma_f32_32x32x16_bf16(kf[5], qr[2], C1, 0, 0, 0),    P1[6], P1[7], P1[8], P1[9],     pw2[2] = PKW(P1, 4),  pw2[3] = PKW(P1, 6),  pw2); \
    VRD(2); SBAR(); GAPA(C0 = __builtin_amdgcn_mfma_f32_32x32x16_bf16(kf[6], qr[3], C0, 0, 0, 0),    P1[10], P1[11], P1[12], P1[13], pw3[0] = PKW(P1, 8),  pw3[1] = PKW(P1, 10), pw3); \
    VRD(3); SBAR(); GAPA(C1 = __builtin_amdgcn_mfma_f32_32x32x16_bf16(kf[7], qr[3], C1, 0, 0, 0),    P1[14], P1[15], 0.f, 0.f,       pw3[2] = PKW(P1, 12), pw3[3] = PKW(P1, 14), pw3); \
    l_reg += sacc; \
    if (GK) { DMA_K((t) + 3, k_cur); } if (GV) { DMA_V((t) + 1, v_next); } \
    if (cls == 1) DIAG_BIAS(C0, C1, t); \
    { float a_ = fmaxf(fmaxf(C0[0], C0[1]), C1[0]), b_ = fmaxf(fmaxf(C0[2], C0[3]), C1[1]); a_ = fmaxf(fmaxf(a_, C1[2]), C1[3]); \
      _Pragma("unroll") for (int r = 4; r < 16; r += 4) { a_ = fmaxf(fmaxf(a_, C0[r]), C0[r + 1]); b_ = fmaxf(fmaxf(b_, C0[r + 2]), C0[r + 3]); a_ = fmaxf(fmaxf(a_, C1[r]), C1[r + 1]); b_ = fmaxf(fmaxf(b_, C1[r + 2]), C1[r + 3]); } \
      float rm_ = fmaxf(a_, b_); { auto rr_ = __builtin_amdgcn_permlane32_swap(__float_as_uint(rm_), __float_as_uint(rm_), false, false); rm_ = fmaxf(__uint_as_float(rr_[0]), __uint_as_float(rr_[1])); } \
      resc = false; \
      if (__builtin_expect(__any(rm_ > THR), 0)) { const float dl_ = fmaxf(rm_, 0.f); mhat += dl_; \
        _Pragma("unroll") for (int r = 0; r < 16; ++r) { C0[r] -= dl_; C1[r] -= dl_; } \
        SET_CINIT(TBIAS(cls) - mhat); \
        const float f_ = __builtin_amdgcn_exp2f(-dl_); l_reg *= f_; if (hi == 0) wsf[r32] = f_; resc = true; } } \
    SBAR(); \
    PVM(0, C0, 0);  VRD(4);  SBAR(); \
    PVM(1, C0, 2);  VRD(5);  SBAR(); \
    PVM(2, C0, 4);  VRD(6);  if (GL) { KLOAD2(kn_, 0); } SBAR(); \
    PVM(3, C0, 6);  VRD(7);  SBAR(); \
    PVM(4, C0, 8);  VRD(8);  if (GL) { KLOAD2(kn_, 1); } SBAR(); \
    PVM(5, C0, 10); VRD(9);  SBAR(); \
    PVM(6, C0, 12); VRD(10); if (GL) { KLOAD2(kn_, 2); } SBAR(); \
    PVM(7, C0, 14); VRD(11); SBAR(); \
    PVM(8, C1, 0);  VRD(12); if (GL) { KLOAD2(kn_, 3); } SBAR(); \
    PVM(9, C1, 2);  VRD(13); SBAR(); \
    PVM(10, C1, 4); VRD(14); SBAR(); \
    PVM(11, C1, 6); VRD(15); SBAR(); \
    PVM(12, C1, 8);  SBAR(); \
    PVM(13, C1, 10); SBAR(); \
    PVM(14, C1, 12); SBAR(); \
    PVM(15, C1, 14); SBAR(); \
    } while (0)
#define RESC() do { if (resc) { LDS_WAIT(); _Pragma("unroll") for (int r = 0; r < 16; ++r) { const float fr_ = wsf[crow(r, hi)]; _Pragma("unroll") for (int d_ = 0; d_ < 4; ++d_) o[d_][r] *= fr_; } } } while (0)
#define ROT() do { k_cur = k_next; k_next = (k_next == 2) ? 0 : k_next + 1; v_prev = v_cur; v_cur = v_next; v_next = (v_next == 2) ? 0 : v_next + 1; } while (0)
    int k_cur = 1, k_next = 2, v_prev = 0, v_cur = 1, v_next = 2;
    int t = 1;
    for (; t + 4 < NT; t += 2) {
        STEP(pB0, pB1, pA0, pA1, t, true, true, true);     DA_WAIT_BAR(4); RESC(); ROT();
        STEP(pA0, pA1, pB0, pB1, t + 1, true, true, true); DA_WAIT_BAR(4); RESC(); ROT();
    }
    STEP(pB0, pB1, pA0, pA1, NT - 3, false, true, true);  DA_WAIT_BAR(2); RESC(); ROT();
    STEP(pA0, pA1, pB0, pB1, NT - 2, false, true, true);  DA_WAIT_BAR(0); RESC(); ROT();
    STEP(pB0, pB1, pA0, pA1, NT - 1, false, false, false); RESC();
    { float sacc = pB0[0] + pB0[1];
#pragma unroll
      for (int r = 2; r < 16; ++r) sacc += pB0[r];
#pragma unroll
      for (int r = 0; r < 16; ++r) sacc += pB1[r];
      l_reg += sacc;
      pw0 = (v4u){PKW(pB0, 0), PKW(pB0, 2), PKW(pB0, 4), PKW(pB0, 6)}; pw1 = (v4u){PKW(pB0, 8), PKW(pB0, 10), PKW(pB0, 12), PKW(pB0, 14)};
      pw2 = (v4u){PKW(pB1, 0), PKW(pB1, 2), PKW(pB1, 4), PKW(pB1, 6)}; pw3 = (v4u){PKW(pB1, 8), PKW(pB1, 10), PKW(pB1, 12), PKW(pB1, 14)};
      const LAS char* vp_ = vp0 + v_cur * DA_VS;
#pragma unroll
      for (int d0 = 0; d0 < 4; ++d0) {
          { const s16x4 lo = vtr(vp_ + d0 * 4096), hh = vtr(vp_ + d0 * 4096 + 512); o[d0] = __builtin_amdgcn_mfma_f32_32x32x16_bf16(PAF(0), ((bf16x8){lo[0], lo[1], lo[2], lo[3], hh[0], hh[1], hh[2], hh[3]}), o[d0], 0, 0, 0); }
          { const s16x4 lo = vtr(vp_ + d0 * 4096 + 1024), hh = vtr(vp_ + d0 * 4096 + 1024 + 512); o[d0] = __builtin_amdgcn_mfma_f32_32x32x16_bf16(PAF(1), ((bf16x8){lo[0], lo[1], lo[2], lo[3], hh[0], hh[1], hh[2], hh[3]}), o[d0], 0, 0, 0); }
          { const s16x4 lo = vtr(vp_ + d0 * 4096 + 2048), hh = vtr(vp_ + d0 * 4096 + 2048 + 512); o[d0] = __builtin_amdgcn_mfma_f32_32x32x16_bf16(PAF(2), ((bf16x8){lo[0], lo[1], lo[2], lo[3], hh[0], hh[1], hh[2], hh[3]}), o[d0], 0, 0, 0); }
          { const s16x4 lo = vtr(vp_ + d0 * 4096 + 3072), hh = vtr(vp_ + d0 * 4096 + 3072 + 512); o[d0] = __builtin_amdgcn_mfma_f32_32x32x16_bf16(PAF(3), ((bf16x8){lo[0], lo[1], lo[2], lo[3], hh[0], hh[1], hh[2], hh[3]}), o[d0], 0, 0, 0); }
      } }
#undef DMA_K
#undef DMA_V
#undef SGP
#undef TCLASS
#undef TBIAS
#undef SET_CINIT
#undef DIAG_BIAS
#undef KLOAD2
#undef PKW
#undef PAF
#undef VFR
#undef PIN
#undef EX
#undef VRD
#undef GAPA
#undef PVM
#undef STEP
#undef RESC
#undef ROT
    float lsum = l_reg;
    asm volatile("s_waitcnt lgkmcnt(0)\n\ts_barrier" ::: "memory");
    { auto rr = __builtin_amdgcn_permlane32_swap(__float_as_uint(lsum), __float_as_uint(lsum), false, false); lsum = __uint_as_float(rr[0]) + __uint_as_float(rr[1]); }
    if (hi == 0) wsf[32 + r32] = 1.0f / lsum;
    LDS_WAIT();
    LAS float* ex = (LAS float*)lds + wid * 4096;
#pragma unroll
    for (int r = 0; r < 16; ++r) { const int row = crow(r, hi); const float rl = wsf[32 + row];
#pragma unroll
        for (int d = 0; d < 4; ++d) ex[row * 128 + d * 32 + r32] = o[d][r] * rl; }
    asm volatile("s_waitcnt lgkmcnt(0)\n\ts_barrier" ::: "memory");
    {
        const float g0 = subln_g[2 * lane], g1 = subln_g[2 * lane + 1];
#pragma unroll 4
        for (int j = 0; j < 16; ++j) { const int qi = wid * 16 + j, w1 = qi >> 5, rr_ = qi & 31;
            const LAS float* e1 = (const LAS float*)lds + w1 * 4096 + rr_ * 128 + 2 * lane; const LAS float* e2 = e1 + 4 * 4096;
            const float d0v = e1[0] - lam * e2[0], d1v = e1[1] - lam * e2[1];
            const float ss = wave_sum(d0v * d0v + d1v * d1v);
            const float rs = __builtin_amdgcn_rsqf(ss * (1.0f / 128.0f) + DA_EPS) * out_scale;
            *(unsigned*)(OB + (rowbase + q0 + qi) * D + h * 128 + 2 * lane) = pk2(d0v * rs * g0, d1v * rs * g1); }
    }
    asm volatile("s_waitcnt lgkmcnt(0)\n\ts_barrier" ::: "memory");
}

__device__ __forceinline__ void na_unit(int b, int h, int g, const bf16* HB, bf16* OB, LAS unsigned char* lds, const float* rpb_lh  ) {
    const int tid = tid_opaque(), lane = tid & 63, r32 = lane & 31, hi = lane >> 5; const int wid = __builtin_amdgcn_readfirstlane(tid >> 6);
    const int gr = 4 * g + (wid >> 1), hq = wid & 1;
    const size_t rowbase = (size_t)b * SEQ;
    volatile LAS float* wsf = (volatile LAS float*)(lds + WSF_OFF) + wid * 64;
    LAS float* rp = (LAS float*)(lds + RPB_OFF);
    if (tid < 465) rp[tid] = rpb_lh[tid] * LOG2E;
    const int ulo = min(max(4 * g - 4, 0), GROWS - 8), uhi = min(max(4 * g - 1, 0), GROWS - 8) + 8, NT = uhi - ulo;
    const int rs = min(max(gr - 4, 0), GROWS - 8);
    const bf16* Qw = HB + (rowbase + (size_t)gr * 64 + hq * 32) * PW + 1536 + h * 64;
    const bf16* ksrc = HB + (rowbase + (size_t)ulo * 64 + lane) * PW + 2048 + h * 64 + wid * 8;
    const bf16* vsrc = HB + (rowbase + (size_t)ulo * 64 + 16 * (wid & 3) + (lane >> 2)) * PW + 2560 + h * 64 + 32 * (wid >> 2) + (lane & 3) * 8;
    LAS unsigned char* kdst = lds + wid * 1024; LAS unsigned char* vdst = lds + 8192 + wid * 1024;
#define NA_DMA(t, slot) do { const size_t to_ = (size_t)(t) * 64 * PW; glds16(ksrc + to_, kdst + (slot)); glds16(vsrc + to_, vdst + (slot)); } while (0)
    NA_DMA(0, 0);
    bf16x8 qr[4];
#pragma unroll
    for (int d0 = 0; d0 < 4; ++d0) qr[d0] = *(const bf16x8*)(Qw + (size_t)r32 * PW + d0 * 16 + hi * 8);
    float mhat = 0.f, lsum = 0.f; f32x16 o[2];
#pragma unroll
    for (int d = 0; d < 2; ++d)
#pragma unroll
        for (int r = 0; r < 16; ++r) o[d][r] = 0.f;
    const LAS char* kb0 = (const LAS char*)lds + hi * 1024 + r32 * 16;
    const LAS char* vb0 = (const LAS char*)lds + 8192 + ((lane >> 4) & 1) * 32 + (lane & 3) * 8 + (4 * hi + ((lane & 15) >> 2)) * 64;
    const int qc = hq * 32 + r32, cs = min(max(qc - 8, 0), GRIDW - 16);
    ATT_WAIT_BAR();
    bool first = true;
    for (int t = 0; t < NT; ++t) {
        const int cur = (t & 1) * 16384;
        if (t + 1 < NT) NA_DMA(t + 1, cur ^ 16384);
        const int u = ulo + t;
        if (u >= rs && u < rs + 8) {
            f32x16 p0, p1;
            qkt(p0, p1, kb0 + cur, qr, -mhat);
            const int ro = (u - gr + 7) * 31 + 15 - qc;
#pragma unroll
            for (int r = 0; r < 16; ++r) { const int kc0 = crow(r, hi), kc1 = kc0 + 32;
                const bool ok0 = (unsigned)(kc0 - cs) < 16u, ok1 = (unsigned)(kc1 - cs) < 16u;
                const float b0 = rp[ok0 ? ro + kc0 : 0], b1 = rp[ok1 ? ro + kc1 : 0];
                p0[r] = ok0 ? p0[r] + b0 : -INFINITY; p1[r] = ok1 ? p1[r] + b1 : -INFINITY; }
            softmax_pv<2>(p0, p1, mhat, lsum, o, first, wsf, vb0 + cur, r32, hi);
            first = false;
        }
        ATT_WAIT_BAR();
    }
#undef NA_DMA
    { auto rr = __builtin_amdgcn_permlane32_swap(__float_as_uint(lsum), __float_as_uint(lsum), false, false); lsum = __uint_as_float(rr[0]) + __uint_as_float(rr[1]); }
    if (hi == 0) wsf[32 + r32] = 1.0f / lsum;
    LDS_WAIT();
    LAS bf16* stg = (LAS bf16*)(lds + 65536) + wid * 2048;
#pragma unroll
    for (int r = 0; r < 16; ++r) { const int row = crow(r, hi); const float rl = wsf[32 + row];
#pragma unroll
        for (int d = 0; d < 2; ++d) stg[row * 64 + d * 32 + r32] = (bf16)(pk2(o[d][r] * rl, 0.f) & 0xffffu); }
    LDS_WAIT();
    bf16* Ow = OB + (rowbase + (size_t)gr * 64 + hq * 32) * D + 512 + h * 64;
#pragma unroll
    for (int i = 0; i < 4; ++i) { const int row = i * 8 + (lane >> 3), ch = lane & 7; const v4u v = *(const LAS v4u*)(stg + row * 64 + ch * 8); *(v4u*)(Ow + (size_t)row * D + ch * 8) = v; }
    asm volatile("s_waitcnt lgkmcnt(0)\n\ts_barrier" ::: "memory");
}

__device__ __forceinline__ int t5_bucket(int rel) {
    const int n = rel < 0 ? -rel : rel; int ret = rel > 0 ? 16 : 0;
    if (n < 8) return ret + n;
    const float v = logf((float)n / 8.0f) / 2.772588722239781f * 8.0f;
    int large = 8 + (int)v; large = large < 15 ? large : 15;
    return ret + large;
}
__device__ __forceinline__ void attn_phase(KP P, int l, LAS unsigned char* lds, int vcu, int G) {
    const int tid = tid_opaque(), lane = tid & 63;
    unsigned char* ws = P->ws;
    const bf16* HB = (const bf16*)(ws + WS_HB); bf16* OB = (bf16*)(ws + WS_OB);
    { LAS float* bt = (LAS float*)(lds + BTAB_OFF);
      for (int i = tid; i < 4 * 257; i += NWAVES * 64) { const int hh = i / 257, j = i % 257; bt[hh * 260 + j] = P->in[I_T5][t5_bucket(j - 128) * 4 + hh] * LOG2E; } }
    const float lam_init = 0.8f - 0.6f * expf(-0.3f * (float)l);
    const float d1 = wave_sum(P->in[I_LQ1][l * 64 + lane] * P->in[I_LK1][l * 64 + lane]);
    const float d2 = wave_sum(P->in[I_LQ2][l * 64 + lane] * P->in[I_LK2][l * 64 + lane]);
    const float lam = __int_as_float(__builtin_amdgcn_readfirstlane(__float_as_int(expf(d1) - expf(d2) + lam_init)));
    __syncthreads();
    for (int U = vcu; U < 16 * 64; U += G) { const int bh = U >> 6, qb = U & 63; da_unit(bh >> 2, bh & 3, qb, HB, OB, lds, lam, 1.0f - lam_init, P->in[I_SUBLN] + l * 128); }
    for (int U = vcu; U < 4 * 8 * 32; U += G) { const int bh = U >> 5, g = U & 31; na_unit(bh >> 3, bh & 7, g, HB, OB, lds, P->in[I_RPB] + ((size_t)l * 8 + (bh & 7)) * 465); }
}
}

__device__ __forceinline__ void ln_router_phase(KP P, int l, LAS unsigned char* lds, int G, int wave, int lane) {
    const int tid = tid_opaque();
    unsigned char* ws = P->ws;
    const float* PRE = (const float*)(ws + WS_PRE); float* X1F = (float*)(ws + WS_X1F); bf16* X1B = (bf16*)(ws + WS_X1B);
    int* TKE = (int*)(ws + WS_TKE); float* TKG = (float*)(ws + WS_TKG); int* SLOT = (int*)(ws + WS_SLOT); int* TOKL = (int*)(ws + WS_TOKL);
    unsigned* cnt = (unsigned*)(ws + WS_CTL) + CW_CNT + 64 * l;
    { const f32x4* rw4 = (const f32x4*)(P->in[I_RW] + (size_t)l * 1024 * 32); LAS f32x4* L4 = (LAS f32x4*)lds;
      for (int i = tid; i < 1024 * 8; i += NWAVES * 64) { const int d = i >> 3, c = i & 7; L4[d * 8 + (c ^ ((d >> 2) & 7))] = rw4[i]; } }
    f32x4 gv[4], bv[4];
#pragma unroll
    for (int j = 0; j < 4; ++j) { gv[j] = *(const f32x4*)(P->in[I_LN1G] + l * 1024 + 256 * j + 4 * lane); bv[j] = *(const f32x4*)(P->in[I_LN1B] + l * 1024 + 256 * j + 4 * lane); }
    const float rbias = P->in[I_RB][l * 32 + (lane >> 1)];
    LAS int* sel = (LAS int*)(lds + SEL_OFF);
    __syncthreads();
    for (int chunk = BLK(); chunk < T / 128; chunk += G) {
        for (int rr = 0; rr < 16; ++rr) {
            const int rloc = wave * 16 + rr; const size_t row = (size_t)chunk * 128 + rloc;
            f32x4 v[4]; float s = 0.f;
#pragma unroll
            for (int j = 0; j < 4; ++j) { v[j] = *(const f32x4*)(PRE + row * D + 256 * j + 4 * lane); s += (v[j][0] + v[j][1]) + (v[j][2] + v[j][3]); }
            const float mean = wave_sum(s) * (1.f / D); float s2 = 0.f;
#pragma unroll
            for (int j = 0; j < 4; ++j) { v[j] = v[j] - mean; s2 += (v[j][0] * v[j][0] + v[j][1] * v[j][1]) + (v[j][2] * v[j][2] + v[j][3] * v[j][3]); }
            const float rstd = 1.f / sqrtf(wave_sum(s2) * (1.f / D) + LN_EPS);
#pragma unroll
            for (int j = 0; j < 4; ++j) { v[j] = v[j] * rstd * gv[j] + bv[j];
                *(f32x4*)(X1F + row * D + 256 * j + 4 * lane) = v[j];
                v2u o; o.x = pk2(v[j][0], v[j][1]); o.y = pk2(v[j][2], v[j][3]); *(v2u*)(X1B + row * D + 256 * j + 4 * lane) = o; }
            float acc[32];
#pragma unroll
            for (int e = 0; e < 32; ++e) acc[e] = 0.f;
#pragma unroll
            for (int j = 0; j < 4; ++j)
#pragma unroll
                for (int i = 0; i < 4; ++i) { const int d = 256 * j + 4 * lane + i; const LAS f32x4* wr = (const LAS f32x4*)lds + d * 8; const float xv = v[j][i];
#pragma unroll
                    for (int c = 0; c < 8; ++c) { const f32x4 w = wr[c ^ (lane & 7)];
                        acc[4 * c + 0] += xv * w[0]; acc[4 * c + 1] += xv * w[1]; acc[4 * c + 2] += xv * w[2]; acc[4 * c + 3] += xv * w[3]; } }
            float a16[16], a8[8], a4[4], a2[2], a1;
            { const bool hb = (lane & 32) != 0;
#pragma unroll
              for (int k = 0; k < 16; ++k) { const float mine = hb ? acc[16 + k] : acc[k], oth = hb ? acc[k] : acc[16 + k]; a16[k] = mine + __shfl_xor(oth, 32); } }
            { const bool hb = (lane & 16) != 0;
#pragma unroll
              for (int k = 0; k < 8; ++k) { const float mine = hb ? a16[8 + k] : a16[k], oth = hb ? a16[k] : a16[8 + k]; a8[k] = mine + __shfl_xor(oth, 16); } }
            { const bool hb = (lane & 8) != 0;
#pragma unroll
              for (int k = 0; k < 4; ++k) { const float mine = hb ? a8[4 + k] : a8[k], oth = hb ? a8[k] : a8[4 + k]; a4[k] = mine + __shfl_xor(oth, 8); } }
            { const bool hb = (lane & 4) != 0;
#pragma unroll
              for (int k = 0; k < 2; ++k) { const float mine = hb ? a4[2 + k] : a4[k], oth = hb ? a4[k] : a4[2 + k]; a2[k] = mine + __shfl_xor(oth, 4); } }
            { const bool hb = (lane & 2) != 0; const float mine = hb ? a2[1] : a2[0], oth = hb ? a2[0] : a2[1]; a1 = mine + __shfl_xor(oth, 2); }
            a1 += __shfl_xor(a1, 1);
            float lgv = a1 + rbias; int si[4]; float sv[4];
#pragma unroll
            for (int k = 0; k < 4; ++k) { float mx = lgv;
#pragma unroll
                for (int o = 1; o < 64; o <<= 1) mx = fmaxf(mx, __shfl_xor(mx, o));
                const unsigned long long bm = __ballot(lgv == mx); const int fl = __builtin_ctzll(bm);
                si[k] = fl >> 1; sv[k] = mx; if ((lane >> 1) == (fl >> 1)) lgv = -INFINITY; }
            const float e1 = expf(sv[1] - sv[0]), e2 = expf(sv[2] - sv[0]), e3 = expf(sv[3] - sv[0]); const float inv = 1.0f / (1.0f + e1 + e2 + e3);
            if (lane == 0) { *(f32x4*)(TKG + row * 4) = (f32x4){inv, e1 * inv, e2 * inv, e3 * inv};
                *(v4u*)(TKE + row * 4) = (v4u){(unsigned)si[0], (unsigned)si[1], (unsigned)si[2], (unsigned)si[3]};
                sel[rloc * 4 + 0] = si[0]; sel[rloc * 4 + 1] = si[1]; sel[rloc * 4 + 2] = si[2]; sel[rloc * 4 + 3] = si[3]; }
            LDS_WAIT();
        }
        __syncthreads();
        for (int ee = 0; ee < 4; ++ee) { const int e = wave * 4 + ee; int total = 0;
            for (int ch = 0; ch < 8; ++ch) { const unsigned long long m = __ballot(sel[ch * 64 + lane] == e); total += __popcll(m); }
            unsigned base = 0; if (lane == 0 && total > 0) base = xb_add(cnt + e, (unsigned)total);
            base = (unsigned)__builtin_amdgcn_readfirstlane((int)base);
            int run = 0;
            for (int ch = 0; ch < 8; ++ch) { const bool mt = sel[ch * 64 + lane] == e; const unsigned long long m = __ballot(mt);
                if (mt) { const int pos = (int)base + run + __popcll(m & ((1ull << lane) - 1ull)); const int id = chunk * 512 + ch * 64 + lane; TOKL[(size_t)e * T + pos] = id; SLOT[id] = pos; }
                run += __popcll(m); } }
        __syncthreads();
    }
}

__device__ __forceinline__ void sort_phase(KP P, int l, LAS unsigned char* lds, int vcu, int G, int wave, int lane) {
    unsigned char* ws = P->ws;
    LAS int* poff = (LAS int*)(lds + POFF_OFF); LAS unsigned char* te = lds + TILEE_OFF;
    unsigned* cnt = (unsigned*)(ws + WS_CTL) + CW_CNT + 64 * l;
    LAS int* ecnt = (LAS int*)(lds + ECNT_OFF);
    if (threadIdx.x == 0) { int off = 0;
        _Pragma("nounroll") for (int e = 0; e < NE; ++e) { poff[e] = off; int c = (int)xb_ld(cnt + e); c = c > T ? T : c; ecnt[e] = c; const int nt = (c + 255) >> 8; _Pragma("nounroll") for (int i = 0; i < nt; ++i) ((volatile LAS unsigned char*)te)[(off >> 8) + i] = (unsigned char)e; off += nt << 8; }
        poff[NE] = off; }
    __syncthreads();
    const int* TOKL = (const int*)(ws + WS_TOKL); const bf16* X1B = (const bf16*)(ws + WS_X1B); bf16* XS = (bf16*)(ws + WS_XS);
    const int MP = poff[NE];
    for (int s = vcu * NWAVES + wave; s < MP; s += G * NWAVES) {
        const int e = (int)te[s >> 8]; const int i = s - poff[e]; const int c = ecnt[e];
        v4u a = (v4u){0u, 0u, 0u, 0u}, b2 = a;
        if (i < c) { const int id = TOKL[(size_t)e * T + i]; const v4u* src = (const v4u*)(X1B + (size_t)(id >> 2) * D); a = src[lane]; b2 = src[64 + lane]; }
        v4u* dst = (v4u*)(XS + (size_t)s * D); dst[lane] = a; dst[64 + lane] = b2;
    }
}

__device__ __forceinline__ void combine_phase(KP P, int l, LAS unsigned char* lds, int vcu, int G, int wave, int lane) {
    unsigned char* ws = P->ws;
    const LAS int* poff = (const LAS int*)(lds + POFF_OFF);
    const float* X1F = (const float*)(ws + WS_X1F); const bf16* Y = (const bf16*)(ws + WS_Y);
    const int* TKE = (const int*)(ws + WS_TKE); const float* TKG = (const float*)(ws + WS_TKG); const int* SLOT = (const int*)(ws + WS_SLOT);
    float* OUT = (l == DEPTH - 1) ? P->out : (float*)(ws + WS_X2F); bf16* XB = (bf16*)(ws + WS_XB);
    f32x4 gv[4], bv[4];
#pragma unroll
    for (int j = 0; j < 4; ++j) { gv[j] = *(const f32x4*)(P->in[I_LN2G] + l * 1024 + 256 * j + 4 * lane); bv[j] = *(const f32x4*)(P->in[I_LN2B] + l * 1024 + 256 * j + 4 * lane); }
    for (int row = vcu * NWAVES + wave; row < T; row += G * NWAVES) {
        const v4u ei = *(const v4u*)(TKE + (size_t)row * 4), sl = *(const v4u*)(SLOT + (size_t)row * 4); const f32x4 gt = *(const f32x4*)(TKG + (size_t)row * 4);
        f32x4 v[4];
#pragma unroll
        for (int j = 0; j < 4; ++j) v[j] = *(const f32x4*)(X1F + (size_t)row * D + 256 * j + 4 * lane) * DN_ALPHA;
#pragma unroll
        for (int k = 0; k < 4; ++k) { const int e = (int)ei[k] & 31; const size_t srow = (size_t)(poff[e] + (int)sl[k]); const float gk = gt[k];
#pragma unroll
            for (int j = 0; j < 4; ++j) { const v2u y = *(const v2u*)(Y + srow * D + 256 * j + 4 * lane);
                v[j][0] += gk * bf_lo(y.x); v[j][1] += gk * bf_hi(y.x); v[j][2] += gk * bf_lo(y.y); v[j][3] += gk * bf_hi(y.y); } }
        float s = 0.f;
#pragma unroll
        for (int j = 0; j < 4; ++j) s += (v[j][0] + v[j][1]) + (v[j][2] + v[j][3]);
        const float mean = wave_sum(s) * (1.f / D); float s2 = 0.f;
#pragma unroll
        for (int j = 0; j < 4; ++j) { v[j] = v[j] - mean; s2 += (v[j][0] * v[j][0] + v[j][1] * v[j][1]) + (v[j][2] * v[j][2] + v[j][3] * v[j][3]); }
        const float rstd = 1.f / sqrtf(wave_sum(s2) * (1.f / D) + LN_EPS);
#pragma unroll
        for (int j = 0; j < 4; ++j) { v[j] = v[j] * rstd * gv[j] + bv[j];
            *(f32x4*)(OUT + (size_t)row * D + 256 * j + 4 * lane) = v[j];
            v2u o; o.x = pk2(v[j][0], v[j][1]); o.y = pk2(v[j][2], v[j][3]); *(v2u*)(XB + (size_t)row * D + 256 * j + 4 * lane) = o; }
    }
}

#define KPARAMS() ({ KP q_ = (KP)__builtin_amdgcn_kernarg_segment_ptr(); asm volatile("" : "+s"(q_)); q_; })

__device__ __forceinline__ void seam(KP P, LAS unsigned char* lds, int k) {
    if (MK_N_LAUNCHES != 1) return;
    if (!(P->ph_lo <= k && k + 1 < P->ph_hi)) return;
    XcdBarrier b; b.bar = (unsigned*)(P->ws + WS_CTL) + CW_BAR; b.x = xb_xcc_id(); b.st = (volatile LAS unsigned*)(lds + MISC_OFF) + 8;
    xcd_barrier(b);
}
__device__ __forceinline__ void build_offsets(KP P, int l, LAS unsigned char* lds) {
    LAS int* poff = (LAS int*)(lds + POFF_OFF); LAS unsigned char* te = lds + TILEE_OFF; LAS int* ecnt = (LAS int*)(lds + ECNT_OFF);
    unsigned* cnt = (unsigned*)(P->ws + WS_CTL) + CW_CNT + 64 * l;
    if (threadIdx.x == 0) { int off = 0;
        _Pragma("nounroll") for (int e = 0; e < NE; ++e) { poff[e] = off; int c = (int)xb_ld(cnt + e); c = c > T ? T : c; ecnt[e] = c; const int nt = (c + 255) >> 8; _Pragma("nounroll") for (int i = 0; i < nt; ++i) ((volatile LAS unsigned char*)te)[(off >> 8) + i] = (unsigned char)e; off += nt << 8; }
        poff[NE] = off; }
    __syncthreads();
}
template <int l> __device__ __forceinline__ void layer_phases(LAS unsigned char* lds0_) {
#define LDSP() ({ LAS unsigned char* p_ = lds0_; asm volatile("" : "+s"(p_)); p_; })
#define IN(k) (P->ph_lo <= (k) && (k) < P->ph_hi)
#define LANE() (tid_opaque() & 63)
#define WAVE() (__builtin_amdgcn_readfirstlane(tid_opaque() >> 6))

        const int pb = 1 + 8 * l;
        { KP P = KPARAMS(); LAS unsigned char* lds = LDSP(); if (IN(pb + 0)) { unsigned char* ws = P->ws;
            pg8::Gemm g{(const pg8::bf16_t*)(ws + WS_XB), (const pg8::bf16_t*)(ws + WS_WIN) + (size_t)l * PW * D, T, PW, D};
            pg8::TileOrder S; S.init(T / 256, PW / 256, GRD(), BLK(), nullptr, 0);
            pg8::EpiInProj E{(pg8::bf16_t*)(ws + WS_HB), PW, C2};
            pg8::gemm_phase<pg8::EpiInProj, pg8::TileOrder, PG8_ALIGN, PG8_SP2>(lds + RING_OFF, g, S, E);
            seam(KPARAMS(), lds, pb + 0); } }
        { KP P = KPARAMS(); LAS unsigned char* lds = LDSP(); if (IN(pb + 1)) { att::attn_phase(P, l, lds, VCU(), GRD()); seam(KPARAMS(), lds, pb + 1); } }
        { KP P = KPARAMS(); LAS unsigned char* lds = LDSP(); if (IN(pb + 2)) { unsigned char* ws = P->ws;
            pg8::Gemm g{(const pg8::bf16_t*)(ws + WS_OB), (const pg8::bf16_t*)(ws + WS_WOUT) + (size_t)l * D * D, T, D, D};
            pg8::TileOrder S; S.init(T / 256, D / 256, GRD(), BLK(), nullptr, 0);
            pg8::EpiResF32 E{(float*)(ws + WS_PRE), (l == 0) ? P->in[I_X] : (const float*)(ws + WS_X2F), D, DN_ALPHA};
            pg8::gemm_phase<pg8::EpiResF32, pg8::TileOrder, PG8_ALIGN, PG8_SP2>(lds + RING_OFF, g, S, E);
            seam(KPARAMS(), lds, pb + 2); } }
        { KP P = KPARAMS(); LAS unsigned char* lds = LDSP(); if (IN(pb + 3)) { ln_router_phase(P, l, lds, GRD(), WAVE(), LANE()); seam(KPARAMS(), lds, pb + 3); } }
        { KP P = KPARAMS(); LAS unsigned char* lds = LDSP(); if (IN(pb + 4)) { sort_phase(P, l, lds, VCU(), GRD(), WAVE(), LANE()); __syncthreads(); seam(KPARAMS(), lds, pb + 4); }
          else if (P->ph_hi > pb + 4 && P->ph_lo <= pb + 7 && P->ph_lo > pb + 4) build_offsets(P, l, lds); }
        { KP P = KPARAMS(); LAS unsigned char* lds = LDSP(); if (IN(pb + 5)) { unsigned char* ws = P->ws;
            const int MP = ((const LAS int*)(lds + POFF_OFF))[NE];
            pg8::Gemm g{(const pg8::bf16_t*)(ws + WS_XS), (const pg8::bf16_t*)(ws + WS_WGU) + (size_t)l * NE * 2048 * 1024, MP, 2048, D};
            pg8::TileOrder S; S.init(MP / 256, 8, GRD(), BLK(), lds + TILEE_OFF, (size_t)2048 * 1024 * 2);
            pg8::EpiSwiGLU E{(pg8::bf16_t*)(ws + WS_HID), P->in[I_BGU] + (size_t)l * NE * 2048};
            pg8::gemm_phase<pg8::EpiSwiGLU, pg8::TileOrder, PG8_ALIGN, PG8_SP2>(lds + RING_OFF, g, S, E);
            seam(KPARAMS(), lds, pb + 5); } }
        { KP P = KPARAMS(); LAS unsigned char* lds = LDSP(); if (IN(pb + 6)) { unsigned char* ws = P->ws;
            const int MP = ((const LAS int*)(lds + POFF_OFF))[NE];
            pg8::Gemm g{(const pg8::bf16_t*)(ws + WS_HID), (const pg8::bf16_t*)(ws + WS_WDN) + (size_t)l * NE * 1024 * 1024, MP, 1024, DFF};
            pg8::TileOrder S; S.init(MP / 256, 4, GRD(), BLK(), lds + TILEE_OFF, (size_t)1024 * 1024 * 2);
            pg8::EpiDown E{(pg8::bf16_t*)(ws + WS_Y), P->in[I_BDN] + (size_t)l * NE * 1024};
            pg8::gemm_phase<pg8::EpiDown, pg8::TileOrder, PG8_ALIGN, PG8_SP2>(lds + RING_OFF, g, S, E);
            seam(KPARAMS(), lds, pb + 6); } }
        { KP P = KPARAMS(); LAS unsigned char* lds = LDSP(); if (IN(pb + 7)) { combine_phase(P, l, lds, VCU(), GRD(), WAVE(), LANE()); seam(KPARAMS(), lds, pb + 7); } }

#undef IN
#undef LANE
#undef WAVE
#undef LDSP
}
__global__ void __launch_bounds__(NWAVES * 64, 2) mk_fwd(Params Pv) {
    extern __shared__ __attribute__((aligned(16))) unsigned char lds_raw[];
    LAS unsigned char* lds0_ = (LAS unsigned char*)lds_raw;
#define LDSP() ({ LAS unsigned char* p_ = lds0_; asm volatile("" : "+s"(p_)); p_; })
    LAS unsigned char* lds = LDSP();
    for (int u = threadIdx.x; u < (LDS_BYTES - LDSCTL_OFF) / 4; u += NWAVES * 64) ((LAS unsigned*)(lds + LDSCTL_OFF))[u] = 0u;
    __syncthreads();
    if (MK_N_LAUNCHES == 1) { KP P = KPARAMS(); (void)xcd_barrier_post((unsigned*)(P->ws + WS_CTL) + CW_BAR, (volatile LAS unsigned*)(lds + MISC_OFF) + 8); }
#define IN(k) (P->ph_lo <= (k) && (k) < P->ph_hi)
#define LANE() (tid_opaque() & 63)
#define WAVE() (__builtin_amdgcn_readfirstlane(tid_opaque() >> 6))

    { KP P = KPARAMS(); if (IN(0)) { p0_prologue(P, lds, VCU(), GRD(), WAVE(), LANE()); __syncthreads(); seam(KPARAMS(), lds, 0); } }

    layer_phases<0>(lds0_);
    layer_phases<1>(lds0_);
#undef IN
}

extern "C" void kernel_launch(void* const* d_in, const int* in_sizes, int n_in, void* d_out, int out_size, void* d_ws, size_t ws_size, hipStream_t stream) {
    static int grid = 0;
    if (grid == 0) {
        if (n_in != 20 || in_sizes[0] != T * D || out_size != T * D || ws_size < WS_END) { fprintf(stderr, "kernel_launch: unexpected shapes (n_in %d, in0 %d, out %d, ws %zu)\n", n_in, n_in > 0 ? in_sizes[0] : -1, out_size, ws_size); grid = -1; return; }
        int dev = 0, cus = 0, per_cu = 0;
        if (hipGetDevice(&dev) != hipSuccess || hipDeviceGetAttribute(&cus, hipDeviceAttributeMultiprocessorCount, dev) != hipSuccess) { grid = -1; return; }
        if (hipFuncSetAttribute((const void*)mk_fwd, hipFuncAttributeMaxDynamicSharedMemorySize, LDS_BYTES) != hipSuccess) { fprintf(stderr, "kernel_launch: hipFuncSetAttribute failed\n"); grid = -1; return; }
        if (hipOccupancyMaxActiveBlocksPerMultiprocessor(&per_cu, (const void*)mk_fwd, NWAVES * 64, LDS_BYTES) != hipSuccess || per_cu < 1) fprintf(stderr, "kernel_launch: occupancy query reports %d\n", per_cu);
        (void)hipGetLastError();
        grid = cus;
    }
    if (grid < 0) return;
    if (hipMemsetAsync((char*)d_ws + WS_CTL, 0, CTL_ZERO_BYTES, stream) != hipSuccess) return;
    Params p{};
    for (int i = 0; i < 20; ++i) p.in[i] = (const float*)d_in[i];
    p.out = (float*)d_out; p.ws = (unsigned char*)d_ws;
    if (MK_N_LAUNCHES == 1) { p.ph_lo = 0; p.ph_hi = N_PHASES; hipLaunchKernelGGL(mk_fwd, dim3(grid), dim3(NWAVES * 64), LDS_BYTES, stream, p); }
    else { for (int k = 0; k < N_PHASES; ++k) { p.ph_lo = k; p.ph_hi = k + 1; hipLaunchKernelGGL(mk_fwd, dim3(grid), dim3(NWAVES * 64), LDS_BYTES, stream, p); } }
}
```

```cpp
#include <hip/hip_runtime.h>
#include <cstdio>
#include <cstdint>

__device__ __forceinline__ int tid_opaque() { int t = (int)threadIdx.x; asm volatile("" : "+v"(t)); return t; }
__device__ __forceinline__ int sgpr_opaque(int v) { asm volatile("" : "+s"(v)); return v; }
namespace pg8 {
#define PG8_LAS __attribute__((address_space(3)))
typedef unsigned short bf16_t;
typedef short bf16x8 __attribute__((ext_vector_type(8)));
typedef float f32x4 __attribute__((ext_vector_type(4)));
typedef unsigned u32x4 __attribute__((ext_vector_type(4)));
constexpr int BM = 256, BK = 64, HALF = 128, HTB = HALF * BK * 2  , STAGE_BYTES = 8 * HTB, NXCD = 8, WGM = 8;

__host__ __device__ __forceinline__ int lds_byte(int r, int c) { const int st = (r >> 4) * 2 + (c >> 5), rr = r & 15, cc = c & 31, ob = rr * 64 + cc * 2; return st * 1024 + (ob ^ (((ob >> 9) & 1) << 5)); }
__host__ __device__ __forceinline__ void stage_rc(int b, int& R, int& C) { const int st = b / 1024, sb = b % 1024, swz = sb ^ (((sb >> 9) & 1) << 5); R = (st >> 1) * 16 + swz / 64; C = (st & 1) * 32 + (swz % 64) / 2; }
__host__ __device__ __forceinline__ int perm32(int rho) { const int n = rho >> 4, i = rho & 15; return 8 * (i >> 2) + 4 * n + (i & 3); }

struct Unit { int pm, pn, e; size_t boff; };
struct Gemm { const bf16_t* A; const bf16_t* Bt; int M, N, K; };

struct TileOrder {
    int nM, nN, nwg, G, c; const PG8_LAS unsigned char* te; size_t gstride; const PG8_LAS unsigned short* rt;
    __device__ void init(int nM_, int nN_, int G_, int c_, const PG8_LAS unsigned char* te_, size_t gstride_) { nM = nM_; nN = nN_; nwg = nM * nN; G = G_; c = c_; te = te_; gstride = gstride_; rt = nullptr; }
    __device__ __forceinline__ bool next(int i, Unit& u) const {
        const long L = (long)i * G + c; if (L >= nwg) return false;
        int wgid = (int)L; { const int q = nwg / NXCD, r = nwg % NXCD, xcd = wgid % NXCD, off = wgid / NXCD; wgid = (xcd < r ? xcd * (q + 1) : r * (q + 1) + (xcd - r) * q) + off; }
        const int nig = WGM * nN, gid = wgid / nig, fm = gid * WGM, gsz = (nM - fm) < WGM ? (nM - fm) : WGM;
        u.pm = fm + ((wgid % nig) % gsz); u.pn = (wgid % nig) / gsz;
        int e = 0; if (te) e = (int)te[u.pm];
        u.e = __builtin_amdgcn_readfirstlane(e); u.boff = (size_t)u.e * gstride; return true;
    }
    __device__ __forceinline__ void a_ready(const Unit&) const {}
    __device__ __forceinline__ void done(const Unit&) const {}
};

typedef float f32x2 __attribute__((ext_vector_type(2))); typedef __bf16 bf16x2v __attribute__((ext_vector_type(2)));
__device__ __forceinline__ unsigned cvt_pk_bf16(float lo, float hi) { f32x2 v = {lo, hi}; bf16x2v b = __builtin_convertvector(v, bf16x2v); return __builtin_bit_cast(unsigned, b); }

struct EpiInProj {
    static constexpr bool PERM = true, AFTER_DRAIN = false;
    bf16_t* O; int ldc; float qscale;
    __device__ __forceinline__ void operator()(const f32x4 (&acc)[2][2][4][2], const Unit& u, int wr, int wc, int fr, int fq) const {
        const int row0 = u.pm * BM + wr * 64 + fr; const int colt = u.pn * BM;
        const float sc = (colt < 512 || (colt >= 1536 && colt < 2048)) ? qscale : 1.f;
        const int col0 = colt + wc * 32 + 8 * fq;
#pragma unroll
        for (int ai = 0; ai < 2; ++ai)
#pragma unroll
            for (int m = 0; m < 4; ++m) { bf16_t* rowp = O + (size_t)(row0 + ai * HALF + m * 16) * ldc + col0;
#pragma unroll
                for (int bj = 0; bj < 2; ++bj) { f32x4 v0 = acc[ai][bj][m][0] * sc, v1 = acc[ai][bj][m][1] * sc;
                    u32x4 w; w.x = cvt_pk_bf16(v0[0], v0[1]); w.y = cvt_pk_bf16(v0[2], v0[3]); w.z = cvt_pk_bf16(v1[0], v1[1]); w.w = cvt_pk_bf16(v1[2], v1[3]);
                    *(u32x4*)(rowp + bj * HALF) = w; } }
    }
};
struct EpiResF32 {
    static constexpr bool PERM = false, AFTER_DRAIN = false;
    float* C; const float* R; int ldc; float alpha;
    __device__ __forceinline__ void operator()(const f32x4 (&acc)[2][2][4][2], const Unit& u, int wr, int wc, int fr, int fq) const {
        const int row0 = u.pm * BM + wr * 64 + fr, col0 = u.pn * BM + wc * 32 + 4 * fq;
#pragma unroll
        for (int ai = 0; ai < 2; ++ai)
#pragma unroll
            for (int m = 0; m < 4; ++m) { const size_t ro = (size_t)(row0 + ai * HALF + m * 16) * ldc + col0;
#pragma unroll
                for (int bj = 0; bj < 2; ++bj)
#pragma unroll
                    for (int n = 0; n < 2; ++n) { const f32x4 rv = *(const f32x4*)(R + ro + bj * HALF + n * 16); *(f32x4*)(C + ro + bj * HALF + n * 16) = acc[ai][bj][m][n] + rv * alpha; } }
    }
};
struct EpiSwiGLU {
    static constexpr bool PERM = true, AFTER_DRAIN = false;
    bf16_t* H; const float* bias;
    __device__ __forceinline__ void operator()(const f32x4 (&acc)[2][2][4][2], const Unit& u, int wr, int wc, int fr, int fq) const {
        const int row0 = u.pm * BM + wr * 64 + fr; const int c0 = u.pn * HALF + wc * 32 + 8 * fq;
        const float* bg = bias + (size_t)u.e * 2048 + c0; const float* bu = bg + 1024;
        f32x4 g0 = *(const f32x4*)bg, g1 = *(const f32x4*)(bg + 4), u0 = *(const f32x4*)bu, u1 = *(const f32x4*)(bu + 4);
#pragma unroll
        for (int ai = 0; ai < 2; ++ai)
#pragma unroll
            for (int m = 0; m < 4; ++m) { bf16_t* rowp = H + (size_t)(row0 + ai * HALF + m * 16) * 1024 + c0;
                float hv[8];
#pragma unroll
                for (int n = 0; n < 2; ++n) { const f32x4 ga = acc[ai][0][m][n] + (n ? g1 : g0), ua = acc[ai][1][m][n] + (n ? u1 : u0);
#pragma unroll
                    for (int i = 0; i < 4; ++i) { const float g = fminf(ga[i], 7.0f), up = fminf(fmaxf(ua[i], -7.0f), 7.0f);
                        const float sg = __builtin_amdgcn_rcpf(1.0f + __builtin_amdgcn_exp2f(g * (-1.702f * 1.4426950408889634f)));
                        hv[4 * n + i] = (up + 1.0f) * (g * sg); } }
                u32x4 w; w.x = cvt_pk_bf16(hv[0], hv[1]); w.y = cvt_pk_bf16(hv[2], hv[3]); w.z = cvt_pk_bf16(hv[4], hv[5]); w.w = cvt_pk_bf16(hv[6], hv[7]);
                *(u32x4*)rowp = w; }
    }
};
struct EpiDown {
    static constexpr bool PERM = true, AFTER_DRAIN = false;
    bf16_t* Y; const float* bias;
    __device__ __forceinline__ void operator()(const f32x4 (&acc)[2][2][4][2], const Unit& u, int wr, int wc, int fr, int fq) const {
        const int row0 = u.pm * BM + wr * 64 + fr; const int col0 = u.pn * BM + wc * 32 + 8 * fq;
        const float* bp = bias + (size_t)u.e * 1024 + col0;
        f32x4 bv[2][2];
#pragma unroll
        for (int bj = 0; bj < 2; ++bj)
#pragma unroll
            for (int n = 0; n < 2; ++n) bv[bj][n] = *(const f32x4*)(bp + bj * HALF + 4 * n);
#pragma unroll
        for (int ai = 0; ai < 2; ++ai)
#pragma unroll
            for (int m = 0; m < 4; ++m) { bf16_t* rowp = Y + (size_t)(row0 + ai * HALF + m * 16) * 1024 + col0;
#pragma unroll
                for (int bj = 0; bj < 2; ++bj) { const f32x4 v0 = acc[ai][bj][m][0] + bv[bj][0], v1 = acc[ai][bj][m][1] + bv[bj][1];
                    u32x4 w; w.x = cvt_pk_bf16(v0[0], v0[1]); w.y = cvt_pk_bf16(v0[2], v0[3]); w.z = cvt_pk_bf16(v1[0], v1[1]); w.w = cvt_pk_bf16(v1[2], v1[3]);
                    *(u32x4*)(rowp + bj * HALF) = w; } }
    }
};

template <class Epi, class Sched, bool ALIGN_EPI = false, bool SP2 = false, bool GATHER = false>
__device__ __forceinline__ void gemm_phase(PG8_LAS unsigned char* lds, const Gemm g, const Sched& S, const Epi& E) {
    const int tid = tid_opaque(), wid = __builtin_amdgcn_readfirstlane(tid >> 6), lane = tid & 63, wr = wid >> 2, wc = wid & 3, fr = lane & 15, fq = lane >> 4;
    const int K = g.K, nt = K / BK;
    unsigned voffA[2], voffB[2];
#pragma unroll
    for (int i = 0; i < 2; ++i) { int R, C; stage_rc(tid * 16 + i * 8192, R, C); const int Rb = Epi::PERM ? ((R & ~31) + perm32(R & 31)) : R;
        voffA[i] = (unsigned)(R * K + C) * 2u; voffB[i] = (unsigned)(Rb * K + C) * 2u; }
    unsigned vAc[2][2], vAn[2][2], vAx[2][2]; int Rr[2]; unsigned Cb[2];
    if constexpr (GATHER) {
#pragma unroll
        for (int i = 0; i < 2; ++i) { int R, C; stage_rc(tid * 16 + i * 8192, R, C); Rr[i] = R; Cb[i] = (unsigned)C * 2u; }
    }
#define PG8_ROWS(dst, ord) do { const PG8_LAS unsigned short* rt_ = S.rt + (ord) * 256; _Pragma("unroll") for (int h_ = 0; h_ < 2; ++h_) _Pragma("unroll") for (int i_ = 0; i_ < 2; ++i_) \
        dst[h_][i_] = (unsigned)rt_[h_ * 128 + Rr[i_]] * (unsigned)(K * 2) + Cb[i_]; } while (0)
#define PG8_STAGE_A(bufoff, kp, h, nx) do { if constexpr (GATHER) { _Pragma("unroll") for (int _i = 0; _i < 2; ++_i) \
        __builtin_amdgcn_global_load_lds((const unsigned*)((const char*)(kp) + ((nx) ? vAx[h][_i] : vAc[h][_i])), (PG8_LAS unsigned*)(lds + (bufoff) + ldsw + _i * 8192), 16, 0, 0); } \
        else { PG8_STAGE(bufoff, (kp) + (h) * hstep, voffA); } } while (0)
    const size_t kstep = (size_t)(BK * 2);
    const size_t hstep = (size_t)HALF * K * 2;
    const size_t tstep = 2 * hstep;
    const unsigned ldsw = (unsigned)wid * 1024u;
    const int aoff = lds_byte(wr * 64 + fr, fq * 8), boff = lds_byte(wc * 32 + fr, fq * 8);
#define PG8_SA(b, h) (((b) * 2 + (h)) * HTB)
#define PG8_SB(b, h) ((4 + (b) * 2 + (h)) * HTB)
#define PG8_STAGE(bufoff, gbase, voff) do { _Pragma("unroll") for (int _i = 0; _i < 2; ++_i) \
        __builtin_amdgcn_global_load_lds((const unsigned*)((const char*)(gbase) + (voff)[_i]), (PG8_LAS unsigned*)(lds + (bufoff) + ldsw + _i * 8192), 16, 0, 0); } while (0)
#define PG8_LDA(dst, b, h) do { _Pragma("unroll") for (int m = 0; m < 4; ++m) _Pragma("unroll") for (int k = 0; k < 2; ++k) dst[m][k] = *(const PG8_LAS bf16x8*)(lds + PG8_SA(b, h) + aoff + m * 2048 + k * 1024); } while (0)
#define PG8_LDB(dst, b, h) do { _Pragma("unroll") for (int n = 0; n < 2; ++n) _Pragma("unroll") for (int k = 0; k < 2; ++k) dst[n][k] = *(const PG8_LAS bf16x8*)(lds + PG8_SB(b, h) + boff + n * 2048 + k * 1024); } while (0)
#define PG8_MMA(ai, bj, At, Bt) do { __builtin_amdgcn_s_setprio(1); _Pragma("unroll") for (int m = 0; m < 4; ++m) _Pragma("unroll") for (int n = 0; n < 2; ++n) _Pragma("unroll") for (int k = 0; k < 2; ++k) \
        acc[ai][bj][m][n] = __builtin_amdgcn_mfma_f32_16x16x32_bf16(Bt[n][k], At[m][k], acc[ai][bj][m][n], 0, 0, 0); __builtin_amdgcn_s_setprio(0); } while (0)
#define PG8_WAIT_V(n) asm volatile("s_waitcnt vmcnt(" #n ")" ::: "memory")
#define PG8_WAIT_L(n) asm volatile("s_waitcnt lgkmcnt(" #n ")" ::: "memory")
#define PG8_BAR __builtin_amdgcn_s_barrier()
#define PG8_SCHED __builtin_amdgcn_sched_barrier(0)
    Unit cur, nxt; int ui = 0;
    if (!S.next(0, cur)) return;
    f32x4 acc[2][2][4][2];
#pragma unroll
    for (int a = 0; a < 2; ++a)
#pragma unroll
        for (int b = 0; b < 2; ++b)
#pragma unroll
            for (int m = 0; m < 4; ++m)
#pragma unroll
                for (int n = 0; n < 2; ++n) acc[a][b][m][n] = (f32x4){0.f, 0.f, 0.f, 0.f};
    bf16x8 At[4][2], B0[2][2], B1[2][2];
    const char* cA = GATHER ? (const char*)g.A : (const char*)g.A + (size_t)cur.pm * tstep; if constexpr (GATHER) { PG8_ROWS(vAc, 0); }
    const char* cB = (const char*)g.Bt + cur.boff + (size_t)cur.pn * tstep;
    S.a_ready(cur);
    if constexpr (SP2) {
        PG8_STAGE(PG8_SB(0, 0), cB, voffB); PG8_STAGE(PG8_SB(0, 1), cB + hstep, voffB); PG8_STAGE_A(PG8_SA(0, 0), cA, 0, 0); PG8_STAGE_A(PG8_SA(0, 1), cA, 1, 0);
        if (wr == 1) PG8_BAR;
        PG8_WAIT_V(2); PG8_BAR;
        PG8_STAGE(PG8_SB(1, 0), cB + kstep, voffB); PG8_STAGE_A(PG8_SA(1, 0), cA + kstep, 0, 0); PG8_STAGE(PG8_SB(1, 1), cB + hstep + kstep, voffB);
        PG8_WAIT_V(6); PG8_BAR;
    } else {
        PG8_STAGE(PG8_SB(0, 0), cB, voffB); PG8_STAGE_A(PG8_SA(0, 0), cA, 0, 0); PG8_STAGE(PG8_SB(0, 1), cB + hstep, voffB); PG8_STAGE_A(PG8_SA(0, 1), cA, 1, 0);
        if (wr == 1) PG8_BAR;
        PG8_WAIT_V(4); PG8_BAR;
        PG8_STAGE(PG8_SB(1, 0), cB + kstep, voffB); PG8_STAGE_A(PG8_SA(1, 0), cA + kstep, 0, 0); PG8_STAGE(PG8_SB(1, 1), cB + hstep + kstep, voffB);
        PG8_WAIT_V(6); PG8_BAR;
    }
    for (;;) {
        const bool has_next = S.next(ui + 1, nxt);
        const char* nA = (has_next && !GATHER) ? (const char*)g.A + (size_t)nxt.pm * tstep : cA;
        if constexpr (GATHER) { if (has_next) { PG8_ROWS(vAn, ui + 1); } else { _Pragma("unroll") for (int h_ = 0; h_ < 2; ++h_) _Pragma("unroll") for (int i_ = 0; i_ < 2; ++i_) vAn[h_][i_] = vAc[h_][i_]; } } const char* nB = has_next ? (const char*)g.Bt + nxt.boff + (size_t)nxt.pn * tstep : cB;
        for (int t = 0; t < nt; t += 2) {
            const bool last = (t == nt - 2);
            const char* a1 = cA + (size_t)(t + 1) * kstep;
            const char* a2 = last ? nA : cA + (size_t)(t + 2) * kstep; const char* b2 = last ? nB : cB + (size_t)(t + 2) * kstep;
            const char* a3 = a2 + kstep; const char* b3 = b2 + kstep;
            if constexpr (GATHER) { _Pragma("unroll") for (int h_ = 0; h_ < 2; ++h_) _Pragma("unroll") for (int i_ = 0; i_ < 2; ++i_) vAx[h_][i_] = last ? vAn[h_][i_] : vAc[h_][i_]; }
            if (last && has_next) S.a_ready(nxt);
            if constexpr (SP2) {
            PG8_LDB(B0, 0, 0); PG8_LDB(B1, 0, 1); PG8_SCHED; PG8_LDA(At, 0, 0); PG8_STAGE_A(PG8_SA(1, 1), a1, 1, 0);
            PG8_WAIT_V(8); PG8_WAIT_L(0); PG8_BAR; PG8_MMA(0, 0, At, B0); PG8_MMA(0, 1, At, B1); PG8_BAR; PG8_SCHED;
            PG8_LDA(At, 0, 1); PG8_STAGE(PG8_SB(0, 0), b2, voffB); PG8_STAGE(PG8_SB(0, 1), b2 + hstep, voffB); PG8_STAGE_A(PG8_SA(0, 0), a2, 0, 1);
            PG8_WAIT_V(8); PG8_WAIT_L(0); PG8_BAR; PG8_MMA(1, 0, At, B0); PG8_MMA(1, 1, At, B1); PG8_BAR; PG8_SCHED;
            PG8_LDB(B0, 1, 0); PG8_LDB(B1, 1, 1); PG8_SCHED; PG8_LDA(At, 1, 0); PG8_STAGE_A(PG8_SA(0, 1), a2, 1, 1);
            PG8_WAIT_V(8); PG8_WAIT_L(0); PG8_BAR; PG8_MMA(0, 0, At, B0); PG8_MMA(0, 1, At, B1); PG8_BAR; PG8_SCHED;
            PG8_LDA(At, 1, 1); PG8_STAGE(PG8_SB(1, 0), b3, voffB); PG8_STAGE(PG8_SB(1, 1), b3 + hstep, voffB); PG8_STAGE_A(PG8_SA(1, 0), a3, 0, 1);
            PG8_WAIT_V(8); PG8_WAIT_L(0); PG8_BAR; PG8_MMA(1, 0, At, B0); PG8_MMA(1, 1, At, B1); PG8_BAR; PG8_SCHED;
            } else {
            PG8_LDB(B0, 0, 0); PG8_SCHED; PG8_LDA(At, 0, 0); PG8_STAGE_A(PG8_SA(1, 1), a1, 1, 0);
            PG8_WAIT_L(8); PG8_BAR; PG8_WAIT_L(0); PG8_MMA(0, 0, At, B0); PG8_BAR; PG8_SCHED;
            PG8_LDB(B1, 0, 1); PG8_STAGE(PG8_SB(0, 0), b2, voffB);
            PG8_BAR; PG8_WAIT_L(0); PG8_MMA(0, 1, At, B1); PG8_BAR;
            PG8_LDA(At, 0, 1); PG8_STAGE_A(PG8_SA(0, 0), a2, 0, 1);
            PG8_BAR; PG8_WAIT_L(0); PG8_MMA(1, 0, At, B0); PG8_BAR; PG8_SCHED;
            PG8_STAGE(PG8_SB(0, 1), b2 + hstep, voffB);
            PG8_WAIT_V(6); PG8_BAR; PG8_MMA(1, 1, At, B1); PG8_BAR;
            PG8_LDB(B0, 1, 0); PG8_SCHED; PG8_LDA(At, 1, 0); PG8_STAGE_A(PG8_SA(0, 1), a2, 1, 1);
            PG8_WAIT_L(8); PG8_BAR; PG8_WAIT_L(0); PG8_MMA(0, 0, At, B0); PG8_BAR; PG8_SCHED;
            PG8_LDB(B1, 1, 1); PG8_STAGE(PG8_SB(1, 0), b3, voffB);
            PG8_BAR; PG8_WAIT_L(0); PG8_MMA(0, 1, At, B1); PG8_BAR;
            PG8_LDA(At, 1, 1); PG8_STAGE_A(PG8_SA(1, 0), a3, 0, 1);
            PG8_BAR; PG8_WAIT_L(0); PG8_MMA(1, 0, At, B0); PG8_BAR; PG8_SCHED;
            PG8_STAGE(PG8_SB(1, 1), b3 + hstep, voffB);
            PG8_WAIT_V(6); PG8_BAR; PG8_MMA(1, 1, At, B1); PG8_BAR;
            }
        }
        if constexpr (ALIGN_EPI) { if (wr == 0) PG8_BAR; }
        if constexpr (!Epi::AFTER_DRAIN) { E(acc, cur, wr, wc, fr, fq); S.done(cur); }
        if (!has_next) break;
#pragma unroll
        for (int a = 0; a < 2; ++a)
#pragma unroll
            for (int b = 0; b < 2; ++b)
#pragma unroll
                for (int m = 0; m < 4; ++m)
#pragma unroll
                    for (int n = 0; n < 2; ++n) acc[a][b][m][n] = (f32x4){0.f, 0.f, 0.f, 0.f};
        cur = nxt; cA = nA; cB = nB; ++ui;
        if constexpr (GATHER) { _Pragma("unroll") for (int h_ = 0; h_ < 2; ++h_) _Pragma("unroll") for (int i_ = 0; i_ < 2; ++i_) vAc[h_][i_] = vAn[h_][i_]; }
        if constexpr (ALIGN_EPI) { if (wr == 1) PG8_BAR; }
    }
    PG8_WAIT_V(0);
    if constexpr (!ALIGN_EPI) { if (wr == 0) PG8_BAR; }
    PG8_BAR;
    if constexpr (Epi::AFTER_DRAIN) { E.fused(acc, cur, wr, wc, fr, fq, lds, wid, lane); S.done(cur); }
#undef PG8_SA
#undef PG8_SB
#undef PG8_STAGE
#undef PG8_STAGE_A
#undef PG8_ROWS
#undef PG8_LDA
#undef PG8_LDB
#undef PG8_MMA
#undef PG8_WAIT_V
#undef PG8_WAIT_L
#undef PG8_BAR
#undef PG8_SCHED
}
}

#ifndef PG8_SP2
#define PG8_SP2 true
#endif
#ifndef PG8_ALIGN
#define PG8_ALIGN true
#endif
#ifndef MK_N_LAUNCHES
#define MK_N_LAUNCHES 1
#endif

constexpr int NWAVES = 8;
constexpr int NB = 4, SEQ = 8192, T = NB * SEQ, D = 1024, PW = 3072, NE = 32, TOPK = 4, DFF = 1024, DEPTH = 2;
constexpr int GRIDW = 64, GROWS = SEQ / GRIDW;
constexpr int MPAD_MAX = T * TOPK + NE * 256;
constexpr float LN_EPS = 1e-5f, DA_EPS = 1e-5f;
constexpr float LOG2E = 1.4426950408889634f;
constexpr float C2 = 0.125f * LOG2E;
constexpr float DN_ALPHA = 1.4142135623730951f;
constexpr int N_PHASES = 1 + 8 * DEPTH;

constexpr size_t MiB = 1u << 20;
constexpr size_t WS_CTL = 0, CTL_ZERO_BYTES = 1 * MiB;
constexpr size_t WS_WIN = 2 * MiB, WS_WOUT = 14 * MiB, WS_WGU = 18 * MiB, WS_WDN = 274 * MiB;
constexpr size_t WS_XB = 402 * MiB;
constexpr size_t WS_RA = 466 * MiB;
constexpr size_t WS_HB = WS_RA, WS_OB = WS_RA + 192 * MiB, WS_PRE = WS_RA + 256 * MiB, WS_XS = WS_RA, WS_Y = WS_RA;
constexpr size_t WS_X1F = 850 * MiB, WS_X1B = 978 * MiB, WS_HID = 1042 * MiB, WS_X2F = 1314 * MiB;
constexpr size_t WS_TKE = 1442 * MiB, WS_TKG = WS_TKE + 512 * 1024, WS_SLOT = 1443 * MiB, WS_TOKL = 1444 * MiB, WS_RWT = 1448 * MiB, WS_END = 1449 * MiB;
static_assert((size_t)MPAD_MAX * 1024 * 2 <= 272 * MiB, "XS/HID/Y size");
constexpr int CW_BAR = 4096;
constexpr int CW_CNT = 65536;

constexpr int RING_OFF = 0, RING_BYTES = 131072;
constexpr int LDSCTL_OFF = RING_BYTES;
constexpr int MISC_OFF = LDSCTL_OFF;
constexpr int POFF_OFF = LDSCTL_OFF + 256;
constexpr int ECNT_OFF = LDSCTL_OFF + 512;
constexpr int TILEE_OFF = LDSCTL_OFF + 768;
constexpr int BTAB_OFF = LDSCTL_OFF + 2048;
constexpr int RPB_OFF = LDSCTL_OFF + 6400;
constexpr int WSF_OFF = LDSCTL_OFF + 8448;
constexpr int SEL_OFF = LDSCTL_OFF + 10752;
constexpr int LGS_OFF = LDSCTL_OFF + 12800;
constexpr int ROWT_OFF = LDSCTL_OFF + 2048;
constexpr int ROWT_UNITS = 17;
constexpr int LDS_BYTES = 147456;
static_assert(LGS_OFF + 8 * 128 <= LDS_BYTES && ROWT_OFF + ROWT_UNITS * 512 <= SEL_OFF, "LDS map");

#define GAS __attribute__((address_space(1)))
#define LAS __attribute__((address_space(3)))
typedef unsigned short bf16;
typedef unsigned v4u __attribute__((ext_vector_type(4)));
typedef unsigned v2u __attribute__((ext_vector_type(2)));
typedef float f32x4 __attribute__((ext_vector_type(4)));
typedef float f32x16 __attribute__((ext_vector_type(16)));
typedef short bf16x8 __attribute__((ext_vector_type(8)));
typedef short s16x4 __attribute__((ext_vector_type(4)));
typedef GAS unsigned gu32;
#define RLX_AGENT __ATOMIC_RELAXED, __HIP_MEMORY_SCOPE_AGENT
#define LDS_WAIT() asm volatile("s_waitcnt lgkmcnt(0)" ::: "memory")
#define VM_WAIT() asm volatile("s_waitcnt vmcnt(0)" ::: "memory")
__device__ __forceinline__ unsigned pk2(float lo, float hi) { return pg8::cvt_pk_bf16(lo, hi); }
__device__ __forceinline__ float bf_lo(unsigned w) { return __uint_as_float(w << 16); }
__device__ __forceinline__ float bf_hi(unsigned w) { return __uint_as_float(w & 0xffff0000u); }
__device__ __forceinline__ float wave_sum(float v) {
#pragma unroll
    for (int o = 1; o < 64; o <<= 1) v += __shfl_xor(v, o);
    return v;
}

#define GRD() sgpr_opaque((int)gridDim.x)
#define BLK() sgpr_opaque((int)blockIdx.x)
__device__ __forceinline__ int vcu_of(int G, int bx) { return (G % 8 == 0) ? (bx % 8) * (G / 8) + bx / 8 : bx; }
#define VCU() vcu_of(GRD(), BLK())
#define XB_TMO      128
#define XB_XCNT(j)  (256  + 64 * (j))
#define XB_XSUB(j)  (1280 + 64 * (j))
#define XB_XGEN(j)  (2304 + 64 * (j))
#define XB_TOP      3328
#define XB_TOPGEN   3392
#define XCD_BAR_WORDS 3456
#define XB_SPIN_CAP (1u << 18)

__device__ __forceinline__ unsigned xb_ld(unsigned* p)              { return __hip_atomic_load(p, __ATOMIC_RELAXED, __HIP_MEMORY_SCOPE_AGENT); }
__device__ __forceinline__ unsigned xb_add(unsigned* p, unsigned v) { return __hip_atomic_fetch_add(p, v, __ATOMIC_RELAXED, __HIP_MEMORY_SCOPE_AGENT); }
__device__ __forceinline__ unsigned xb_xcc_id() { return (unsigned)__builtin_amdgcn_s_getreg((3 << 11) | 20) & 0xFu; }
#define XB_SPIN(cond, bar) do { unsigned _sp = 0; while (cond) { __builtin_amdgcn_s_sleep(1); \
    if ((++_sp & 255u) == 0u) { if (xb_ld(&(bar)[XB_TMO])) break; if (_sp > XB_SPIN_CAP) { atomicAdd(&(bar)[XB_TMO], 1u); break; } } } } while (0)

struct XcdBarrier { unsigned* bar; unsigned x; volatile LAS unsigned* st; };

__device__ __forceinline__ XcdBarrier xcd_barrier_post(unsigned* bar, volatile LAS unsigned* st) {
    XcdBarrier b; b.bar = bar; b.x = xb_xcc_id(); b.st = st;
    if (threadIdx.x == 0) (void)xb_add(&bar[XB_XCNT(b.x)], 1u);
    return b;
}
__device__ __forceinline__ void xcd_barrier_complete(unsigned* bar, unsigned x, unsigned& nloc, unsigned& nx) {
    const unsigned G = gridDim.x * gridDim.y * gridDim.z;
    unsigned sum, cnt, mine, sp = 0u;
    for (;;) {
        sum = 0u; cnt = 0u; mine = 0u;
#pragma unroll
        for (unsigned j = 0; j < 16; ++j) { const unsigned c = xb_ld(&bar[XB_XCNT(j)]); sum += c; cnt += (c > 0u) ? 1u : 0u; mine = (j == x) ? c : mine; }
        if (sum == G) break;
        __builtin_amdgcn_s_sleep(1);
        if ((++sp & 255u) == 0u) { if (xb_ld(&bar[XB_TMO])) break; if (sp > XB_SPIN_CAP) { atomicAdd(&bar[XB_TMO], 1u); break; } }
    }
    nloc = mine > 0u ? mine : 1u; nx = cnt > 0u ? cnt : 1u;
}
__device__ __forceinline__ void xcd_barrier(const XcdBarrier& b) {
    asm volatile("s_waitcnt vmcnt(0)" ::: "memory");
    __syncthreads();
    if (threadIdx.x == 0) {
        unsigned* bar = b.bar;
        __builtin_amdgcn_s_waitcnt(0);
        unsigned nloc = b.st[0], nx = b.st[1];
        if (nloc == 0u) { xcd_barrier_complete(bar, b.x, nloc, nx); b.st[0] = nloc; b.st[1] = nx; }
        const unsigned old = xb_add(&bar[XB_XSUB(b.x)], 1u);
        const unsigned gen = old / nloc;
        if (old + 1u == (gen + 1u) * nloc) {
            __builtin_amdgcn_fence(__ATOMIC_RELEASE, "agent");
            asm volatile("s_waitcnt vmcnt(0)" ::: "memory");
            const unsigned og = xb_add(&bar[XB_TOP], 1u);
            const unsigned tg = og / nx;
            if (og + 1u == (tg + 1u) * nx) xb_add(&bar[XB_TOPGEN], 1u);
            else XB_SPIN(xb_ld(&bar[XB_TOPGEN]) == tg, bar);
            __builtin_amdgcn_fence(__ATOMIC_ACQUIRE, "agent");
            xb_add(&bar[XB_XGEN(b.x)], 1u);
            asm volatile("s_waitcnt vmcnt(0)" ::: "memory");
        } else {
            XB_SPIN(xb_ld(&bar[XB_XGEN(b.x)]) == gen, bar);
            __builtin_amdgcn_fence(__ATOMIC_ACQUIRE, "agent");
            asm volatile("s_waitcnt vmcnt(0)" ::: "memory");
        }
    }
    __syncthreads();
}

struct Params { const float* in[20]; float* out; unsigned char* ws; int ph_lo, ph_hi; };
typedef const __attribute__((address_space(4))) Params* KP;
enum { I_X = 0, I_WIN, I_WOUT, I_LQ1, I_LK1, I_LQ2, I_LK2, I_SUBLN, I_T5, I_RPB, I_LN1G, I_LN1B, I_RW, I_RB, I_WGU, I_BGU, I_WDN, I_BDN, I_LN2G, I_LN2B };

__device__ __forceinline__ void transpose_item(const float* Wsrc  , size_t ldw, bf16* WTdst  , int K, LAS unsigned* scr, int lane) {
    const int l31 = lane & 31, kh = lane >> 5;
    const float* src = Wsrc + (size_t)(2 * kh) * ldw + 4 * l31;
#pragma unroll
    for (int half = 0; half < 2; ++half) {
        f32x4 v0[8], v1[8];
#pragma unroll
        for (int i = 0; i < 8; ++i) { const float* p = src + (size_t)(4 * (8 * half + i)) * ldw; v0[i] = *(const f32x4*)p; v1[i] = *(const f32x4*)(p + ldw); }
#pragma unroll
        for (int i = 0; i < 8; ++i) { const int kp = 2 * (8 * half + i) + kh;
            const int col = kp ^ ((l31 & 7) << 2);
#pragma unroll
            for (int j = 0; j < 4; ++j) scr[(4 * l31 + j) * 32 + col] = pk2(v0[i][j], v1[i][j]); }
    }
    LDS_WAIT(); asm volatile("" ::: "memory");
#pragma unroll
    for (int i2 = 0; i2 < 16; ++i2) { const int n = 8 * i2 + (lane >> 3), c = lane & 7, cs = c ^ ((n >> 2) & 7);
        const v4u o = *(const LAS v4u*)(scr + n * 32 + 4 * cs);
        *(v4u*)(WTdst + (size_t)n * K + 8 * c) = o; }
    LDS_WAIT(); asm volatile("" ::: "memory");
}
__device__ __forceinline__ void p0_prologue(KP P, LAS unsigned char* lds, int vcu, int G, int wave, int lane) {
    LAS unsigned* scr = (LAS unsigned*)(lds + RING_OFF + wave * 16384);
    const int gw = vcu * NWAVES + wave, NGW = G * NWAVES;
    unsigned char* ws = P->ws;
    constexpr int I_GU = 2 * 32 * 256, I_DN = 2 * 32 * 128, I_IN = 2 * 384, I_OUT = 2 * 128, NITEMS = I_GU + I_DN + I_IN + I_OUT;
    for (int it = gw; it < NITEMS; it += NGW) {
        int r = it;
        if (r < I_GU) { const int le = r >> 8, kt = (r >> 4) & 15, nt = r & 15;
            const float* W = P->in[I_WGU] + (size_t)le * 1024 * 2048;
            const int n0 = nt * 128; const int orow = (n0 < 1024) ? (256 * (n0 >> 7)) : (256 * ((n0 - 1024) >> 7) + 128);
            bf16* WT = (bf16*)(ws + WS_WGU) + (size_t)le * 2048 * 1024;
            transpose_item(W + (size_t)(kt * 64) * 2048 + n0, 2048, WT + (size_t)orow * 1024 + kt * 64, 1024, scr, lane); continue; }
        r -= I_GU;
        if (r < I_DN) { const int le = r >> 7, kt = (r >> 3) & 15, nt = r & 7;
            const float* W = P->in[I_WDN] + (size_t)le * 1024 * 1024;
            bf16* WT = (bf16*)(ws + WS_WDN) + (size_t)le * 1024 * 1024;
            transpose_item(W + (size_t)(kt * 64) * 1024 + nt * 128, 1024, WT + (size_t)(nt * 128) * 1024 + kt * 64, 1024, scr, lane); continue; }
        r -= I_DN;
        if (r < I_IN) { const int l = r / 384, q = r % 384, kt = q / 24, nt = q % 24;
            const float* W = P->in[I_WIN] + (size_t)l * 1024 * 3072;
            bf16* WT = (bf16*)(ws + WS_WIN) + (size_t)l * 3072 * 1024;
            transpose_item(W + (size_t)(kt * 64) * 3072 + nt * 128, 3072, WT + (size_t)(nt * 128) * 1024 + kt * 64, 1024, scr, lane); continue; }
        r -= I_IN;
        { const int l = r >> 7, kt = (r >> 3) & 15, nt = r & 7;
            const float* W = P->in[I_WOUT] + (size_t)l * 1024 * 1024;
            bf16* WT = (bf16*)(ws + WS_WOUT) + (size_t)l * 1024 * 1024;
            transpose_item(W + (size_t)(kt * 64) * 1024 + nt * 128, 1024, WT + (size_t)(nt * 128) * 1024 + kt * 64, 1024, scr, lane); }
    }
    { bf16* RWT = (bf16*)(ws + WS_RWT); const float* RW = P->in[I_RW];
      for (int i = gw * 64 + lane; i < 2 * 32 * 1024; i += NGW * 64) { const int l2 = i >> 15, n = (i >> 10) & 31, k = i & 1023; RWT[i] = (bf16)(pk2(RW[(size_t)l2 * 32768 + k * 32 + n], 0.f) & 0xffffu); } }
    const f32x4* x4 = (const f32x4*)P->in[I_X]; v4u* xb = (v4u*)(ws + WS_XB);
    const size_t nchunk = (size_t)T * D / 8, gt = (size_t)gw * 64 + lane, ngt = (size_t)NGW * 64;
    for (size_t i = gt; i < nchunk; i += ngt) { const f32x4 a = x4[2 * i], b = x4[2 * i + 1]; v4u o; o.x = pk2(a[0], a[1]); o.y = pk2(a[2], a[3]); o.z = pk2(b[0], b[1]); o.w = pk2(b[2], b[3]); xb[i] = o; }
}

namespace att {
__device__ __forceinline__ int crow(int r, int hi) { return (r & 3) + 8 * (r >> 2) + 4 * hi; }
__device__ __forceinline__ void glds16(const void* gsrc, LAS unsigned char* lds_dst) {
    __builtin_amdgcn_global_load_lds((const unsigned*)gsrc, (LAS unsigned*)lds_dst, 16, 0, 0); }
typedef short v4i16_t __attribute__((ext_vector_type(4)));
__device__ __forceinline__ s16x4 vtr(const LAS char* p) { return __builtin_bit_cast(s16x4, __builtin_amdgcn_ds_read_tr16_b64_v4i16((LAS v4i16_t*)p)); }
#define ATT_WAIT_BAR() asm volatile("s_waitcnt vmcnt(0) lgkmcnt(0)\n\ts_barrier" ::: "memory")
constexpr float THR = 8.0f;

__device__ __forceinline__ void qkt(f32x16& p0, f32x16& p1, const LAS char* kb, const bf16x8 (&qr)[4], float ci) {
    f32x16 c;
#pragma unroll
    for (int r = 0; r < 16; ++r) c[r] = ci;
#pragma unroll
    for (int d0 = 0; d0 < 4; ++d0) {
        const bf16x8 b0 = *(const LAS bf16x8*)(kb + d0 * 2048);
        const bf16x8 b1 = *(const LAS bf16x8*)(kb + d0 * 2048 + 512);
        if (d0 == 0) { p0 = __builtin_amdgcn_mfma_f32_32x32x16_bf16(b0, qr[0], c, 0, 0, 0); p1 = __builtin_amdgcn_mfma_f32_32x32x16_bf16(b1, qr[0], c, 0, 0, 0); }
        else { p0 = __builtin_amdgcn_mfma_f32_32x32x16_bf16(b0, qr[d0], p0, 0, 0, 0); p1 = __builtin_amdgcn_mfma_f32_32x32x16_bf16(b1, qr[d0], p1, 0, 0, 0); }
    }
}
template <int NEB>
__device__ __forceinline__ void softmax_pv(f32x16& p0, f32x16& p1, float& mhat, float& lsum, f32x16 (&o)[NEB], bool force, volatile LAS float* wsf, const LAS char* vb, int r32, int hi) {
    float rm = fmaxf(p0[0], p1[0]);
#pragma unroll
    for (int r = 1; r < 16; ++r) rm = fmaxf(rm, fmaxf(p0[r], p1[r]));
    { auto rr = __builtin_amdgcn_permlane32_swap(__float_as_uint(rm), __float_as_uint(rm), false, false); rm = fmaxf(__uint_as_float(rr[0]), __uint_as_float(rr[1])); }
    if (force || __any(rm > THR)) {
        const float dl = force ? rm : fmaxf(rm, 0.f);
        mhat += dl;
#pragma unroll
        for (int r = 0; r < 16; ++r) { p0[r] -= dl; p1[r] -= dl; }
        if (!force) {
            const float f = __builtin_amdgcn_exp2f(-dl);
            lsum *= f;
            if (hi == 0) wsf[r32] = f;
            LDS_WAIT();
#pragma unroll
            for (int r = 0; r < 16; ++r) { const float fr = wsf[crow(r, hi)];
#pragma unroll
                for (int d = 0; d < NEB; ++d) o[d][r] *= fr; }
        }
    }
    float s = 0.f;
#pragma unroll
    for (int r = 0; r < 16; ++r) { p0[r] = __builtin_amdgcn_exp2f(p0[r]); p1[r] = __builtin_amdgcn_exp2f(p1[r]); s += p0[r] + p1[r]; }
    lsum += s;
    v4u pw[4];
    pw[0] = (v4u){pk2(p0[0], p0[1]), pk2(p0[2], p0[3]), pk2(p0[4], p0[5]), pk2(p0[6], p0[7])};
    pw[1] = (v4u){pk2(p0[8], p0[9]), pk2(p0[10], p0[11]), pk2(p0[12], p0[13]), pk2(p0[14], p0[15])};
    pw[2] = (v4u){pk2(p1[0], p1[1]), pk2(p1[2], p1[3]), pk2(p1[4], p1[5]), pk2(p1[6], p1[7])};
    pw[3] = (v4u){pk2(p1[8], p1[9]), pk2(p1[10], p1[11]), pk2(p1[12], p1[13]), pk2(p1[14], p1[15])};
#pragma unroll
    for (int d0 = 0; d0 < NEB; ++d0)
#pragma unroll
        for (int ks = 0; ks < 4; ++ks) {
            const s16x4 lo = vtr(vb + d0 * 4096 + ks * 1024), hh = vtr(vb + d0 * 4096 + ks * 1024 + 512);
            const bf16x8 vf = (bf16x8){lo[0], lo[1], lo[2], lo[3], hh[0], hh[1], hh[2], hh[3]};
            o[d0] = __builtin_amdgcn_mfma_f32_32x32x16_bf16(__builtin_bit_cast(bf16x8, pw[ks]), vf, o[d0], 0, 0, 0);
        }
}

__device__ __forceinline__ void glds16a(const void* sbase, unsigned voff, unsigned lds_dst) { unsigned keep;
    asm volatile("s_mov_b32 %0, m0\n\ts_mov_b32 m0, %3\n\ts_nop 0\n\tglobal_load_lds_dwordx4 %1, %2\n\ts_mov_b32 m0, %0" : "=&s"(keep) : "v"(voff), "s"(sbase), "s"(lds_dst) : "memory"); }
#define DA_WAIT_BAR(N) asm volatile("s_waitcnt vmcnt(" #N ") lgkmcnt(0)\n\ts_barrier" ::: "memory")
#define SBAR() __builtin_amdgcn_sched_barrier(0)
constexpr int DA_K1 = 0, DA_K2 = 24576, DA_V = 49152, DA_KS = 8192, DA_VS = 16384;
__device__ __forceinline__ void da_unit(int b, int h, int qb, const bf16* HB, bf16* OB, LAS unsigned char* lds, float lam, float out_scale, const float* subln_g) {
    const int tid = tid_opaque(), lane = tid & 63, r32 = lane & 31, hi = lane >> 5; const int wid = __builtin_amdgcn_readfirstlane(tid >> 6);
    const int br = wid >> 2, qw = wid & 3;
    const size_t rowbase = (size_t)b * SEQ; const int q0 = qb * 128, q0w = q0 + qw * 32;
    const bf16* Qw = HB + (rowbase + q0w) * PW + br * 256 + h * 64;
    const bf16* Kh = HB + rowbase * PW + 512 + br * 256 + h * 64;
    const bf16* Vh = HB + rowbase * PW + 1024 + h * 128;
    const unsigned lds0 = (unsigned)(uintptr_t)lds;
    volatile LAS float* wsf = (volatile LAS float*)(lds + WSF_OFF) + wid * 64;
    const LAS float* bt = (const LAS float*)(lds + BTAB_OFF) + h * 260;
    const int vpi0 = 2 * wid;
    const unsigned kvoff = (unsigned)(lane * PW + (2 * qw) * 8) * 2u;
    const unsigned vvoff = (unsigned)((16 * (vpi0 & 3) + (lane >> 2)) * PW + 32 * (vpi0 >> 2) + (lane & 3) * 8) * 2u;
    const unsigned kdst = lds0 + (br ? DA_K2 : DA_K1) + (2 * qw) * 1024, vdst = lds0 + DA_V + vpi0 * 1024;
#define SGP(p) ((const char*)(((unsigned long long)(unsigned)__builtin_amdgcn_readfirstlane((int)((unsigned long long)(p) >> 32)) << 32) | (unsigned)__builtin_amdgcn_readfirstlane((int)(unsigned long long)(p))))
#define DMA_K(t, slot) do { const char* kb_ = SGP((const char*)Kh + (size_t)(t) * 64 * PW * 2); glds16a(kb_, kvoff, (unsigned)__builtin_amdgcn_readfirstlane(kdst + (slot) * DA_KS)); glds16a(kb_ + 16, kvoff, (unsigned)__builtin_amdgcn_readfirstlane(kdst + (slot) * DA_KS + 1024)); } while (0)
#define DMA_V(t, slot) do { const char* vb_ = SGP((const char*)Vh + (size_t)(t) * 64 * PW * 2); glds16a(vb_, vvoff, (unsigned)__builtin_amdgcn_readfirstlane(vdst + (slot) * DA_VS)); glds16a(vb_ + 16 * PW * 2, vvoff, (unsigned)__builtin_amdgcn_readfirstlane(vdst + (slot) * DA_VS + 1024)); } while (0)
    const LAS char* kp0 = (const LAS char*)lds + (br ? DA_K2 : DA_K1) + hi * 1024 + r32 * 16;
    const LAS char* vp0 = (const LAS char*)lds + DA_V + ((lane >> 4) & 1) * 32 + (lane & 3) * 8 + (4 * hi + ((lane & 15) >> 2)) * 64;
    constexpr int NT = SEQ / 64;
    DMA_K(0, 0); DMA_V(0, 0); DMA_K(1, 1);
    bf16x8 qr[4];
#pragma unroll
    for (int d0 = 0; d0 < 4; ++d0) qr[d0] = *(const bf16x8*)(Qw + (size_t)r32 * PW + d0 * 16 + hi * 8);
    float mhat = 0.f, l_reg = 0.f; f32x16 o[4];
#pragma unroll
    for (int d = 0; d < 4; ++d)
#pragma unroll
        for (int r = 0; r < 16; ++r) o[d][r] = 0.f;
    const float bneg = __int_as_float(__builtin_amdgcn_readfirstlane(__float_as_int(bt[0]))), bpos = __int_as_float(__builtin_amdgcn_readfirstlane(__float_as_int(bt[256])));
#define TCLASS(t) ((64 * (t) + 63 - q0w <= -128) ? 0 : ((64 * (t) - (q0w + 31) >= 128) ? 2 : 1))
#define TBIAS(c) ((c) == 0 ? bneg : ((c) == 2 ? bpos : 0.f))
    f32x16 cinit;
#define SET_CINIT(v) do { const float v_ = (v); _Pragma("unroll") for (int r = 0; r < 16; ++r) cinit[r] = v_; asm volatile("" : "+v"(cinit)); } while (0)
#define DIAG_BIAS(C0, C1, t) do { const int base_ = 64 * (t) - q0w - r32 + 4 * hi; \
        _Pragma("unroll") for (int r = 0; r < 16; ++r) { const int rel_ = base_ + (r & 3) + 8 * (r >> 2); \
            const int i0_ = min(max(rel_, -128), 128) + 128, i1_ = min(max(rel_ + 32, -128), 128) + 128; C0[r] += bt[i0_]; C1[r] += bt[i1_]; if ((r & 3) == 3) SBAR(); } } while (0)
    int cls = TCLASS(0);
    SET_CINIT(TBIAS(cls));
    DMA_K(2, 2);
    DA_WAIT_BAR(6);
    f32x16 pA0, pA1, pB0, pB1;
    bool resc = false;
    qkt(pA0, pA1, kp0, qr, TBIAS(cls));
    if (cls == 1) DIAG_BIAS(pA0, pA1, 0);
    { float rm = fmaxf(pA0[0], pA1[0]);
#pragma unroll
      for (int r = 1; r < 16; ++r) rm = fmaxf(rm, fmaxf(pA0[r], pA1[r]));
      { auto rr = __builtin_amdgcn_permlane32_swap(__float_as_uint(rm), __float_as_uint(rm), false, false); rm = fmaxf(__uint_as_float(rr[0]), __uint_as_float(rr[1])); }
      mhat = rm;
#pragma unroll
      for (int r = 0; r < 16; ++r) { pA0[r] = __builtin_amdgcn_exp2f(pA0[r] - rm); pA1[r] = __builtin_amdgcn_exp2f(pA1[r] - rm); } }
    SET_CINIT(TBIAS(cls) - mhat);
    DA_WAIT_BAR(0);
    DMA_K(3, 0); DMA_V(1, 1);
    bf16x8 kf[8];
#define KLOAD2(kp, j) do { kf[2 * (j)] = *(const LAS bf16x8*)((kp) + (j) * 2048); kf[2 * (j) + 1] = *(const LAS bf16x8*)((kp) + (j) * 2048 + 512); } while (0)
    KLOAD2(kp0 + DA_KS, 0); KLOAD2(kp0 + DA_KS, 1); KLOAD2(kp0 + DA_KS, 2); KLOAD2(kp0 + DA_KS, 3);
    DA_WAIT_BAR(4);
    s16x4 vlo[4], vhi[4]; v4u pw0, pw1, pw2, pw3;
#define PKW(P, B) pk2(P[B], P[(B) + 1])
#define PAF(k) __builtin_bit_cast(bf16x8, pw##k)
#define VFR(i) ((bf16x8){vlo[i][0], vlo[i][1], vlo[i][2], vlo[i][3], vhi[i][0], vhi[i][1], vhi[i][2], vhi[i][3]})
#define PIN(x) asm volatile("" : "+v"(x))
#define EX(v) __builtin_amdgcn_exp2f(v)
#define VRD(f) do { vlo[(f) & 3] = vtr(vp_ + (((f) & 3) * 4096 + ((f) >> 2) * 1024)); vhi[(f) & 3] = vtr(vp_ + (((f) & 3) * 4096 + ((f) >> 2) * 1024 + 512)); } while (0)
#define GAPA(MF, A0, A1, A2, A3, W0, W1, PW) do { MF; sacc += A0; sacc += A1; sacc += A2; sacc += A3; PIN(sacc); W0; W1; PIN(PW); SBAR(); } while (0)
#define PVM(f, X, B) do { o[(f) & 3] = __builtin_amdgcn_mfma_f32_32x32x16_bf16(((f) >> 2) == 0 ? PAF(0) : ((f) >> 2) == 1 ? PAF(1) : ((f) >> 2) == 2 ? PAF(2) : PAF(3), VFR((f) & 3), o[(f) & 3], 0, 0, 0); \
        X[B] = EX(X[B]); X[(B) + 1] = EX(X[(B) + 1]); PIN(X); } while (0)
#define STEP(C0, C1, P0, P1, t, GK, GV, GL) do { SBAR(); \
    const LAS char* vp_ = vp0 + v_prev * DA_VS; const LAS char* kn_ = kp0 + k_next * DA_KS; \
    const int ncls_ = TCLASS(t); if (ncls_ != cls) { cls = ncls_; SET_CINIT(TBIAS(cls) - mhat); } \
    float sacc = (P0[0] + P0[1]); \
    GAPA(C0 = __builtin_amdgcn_mfma_f32_32x32x16_bf16(kf[0], qr[0], cinit, 0, 0, 0), P0[2], P0[3], P0[4], P0[5],     pw0[0] = PKW(P0, 0),  pw0[1] = PKW(P0, 2),  pw0); \
    GAPA(C1 = __builtin_amdgcn_mfma_f32_32x32x16_bf16(kf[1], qr[0], cinit, 0, 0, 0), P0[6], P0[7], P0[8], P0[9],     pw0[2] = PKW(P0, 4),  pw0[3] = PKW(P0, 6),  pw0); \
    GAPA(C0 = __builtin_amdgcn_mfma_f32_32x32x16_bf16(kf[2], qr[1], C0, 0, 0, 0),    P0[10], P0[11], P0[12], P0[13], pw1[0] = PKW(P0, 8),  pw1[1] = PKW(P0, 10), pw1); \
    GAPA(C1 = __builtin_amdgcn_mfma_f32_32x32x16_bf16(kf[3], qr[1], C1, 0, 0, 0),    P0[14], P0[15], P1[0], P1[1],   pw1[2] = PKW(P0, 12), pw1[3] = PKW(P0, 14), pw1); \
    VRD(0); SBAR(); GAPA(C0 = __builtin_amdgcn_mfma_f32_32x32x16_bf16(kf[4], qr[2], C0, 0, 0, 0),    P1[2], P1[3], P1[4], P1[5],     pw2[0] = PKW(P1, 0),  pw2[1] = PKW(P1, 2),  pw2); \
    VRD(1); SBAR(); GAPA(C1 = __builtin_amdgcn_mfma_f32_32x32x16_bf16(kf[5], qr[2], C1, 0, 0, 0),    P1[6], P1[7], P1[8], P1[9],     pw2[2] = PKW(P1, 4),  pw2[3] = PKW(P1, 6),  pw2); \
    VRD(2); SBAR(); GAPA(C0 = __builtin_amdgcn_mfma_f32_32x32x16_bf16(kf[6], qr[3], C0, 0, 0, 0),    P1[10], P1[11], P1[12], P1[13], pw3[0] = PKW(P1, 8),  pw3[1] = PKW(P1, 10), pw3); \
    VRD(3); SBAR(); GAPA(C1 = __builtin_amdgcn_mfma_f32_32x32x16_bf16(kf[7], qr[3], C1, 0, 0, 0),    P1[14], P1[15], 0.f, 0.f,       pw3[2] = PKW(P1, 12), pw3[3] = PKW(P1, 14), pw3); \
    l_reg += sacc; \
    if (GK) { DMA_K((t) + 3, k_cur); } if (GV) { DMA_V((t) + 1, v_next); } \
    if (cls == 1) DIAG_BIAS(C0, C1, t); \
    { float a_ = fmaxf(fmaxf(C0[0], C0[1]), C1[0]), b_ = fmaxf(fmaxf(C0[2], C0[3]), C1[1]); a_ = fmaxf(fmaxf(a_, C1[2]), C1[3]); \
      _Pragma("unroll") for (int r = 4; r < 16; r += 4) { a_ = fmaxf(fmaxf(a_, C0[r]), C0[r + 1]); b_ = fmaxf(fmaxf(b_, C0[r + 2]), C0[r + 3]); a_ = fmaxf(fmaxf(a_, C1[r]), C1[r + 1]); b_ = fmaxf(fmaxf(b_, C1[r + 2]), C1[r + 3]); } \
      float rm_ = fmaxf(a_, b_); { auto rr_ = __builtin_amdgcn_permlane32_swap(__float_as_uint(rm_), __float_as_uint(rm_), false, false); rm_ = fmaxf(__uint_as_float(rr_[0]), __uint_as_float(rr_[1])); } \
      resc = false; \
      if (__builtin_expect(__any(rm_ > THR), 0)) { const float dl_ = fmaxf(rm_, 0.f); mhat += dl_; \
        _Pragma("unroll") for (int r = 0; r < 16; ++r) { C0[r] -= dl_; C1[r] -= dl_; } \
        SET_CINIT(TBIAS(cls) - mhat); \
        const float f_ = __builtin_amdgcn_exp2f(-dl_); l_reg *= f_; if (hi == 0) wsf[r32] = f_; resc = true; } } \
    SBAR(); \
    PVM(0, C0, 0);  VRD(4);  SBAR(); \
    PVM(1, C0, 2);  VRD(5);  SBAR(); \
    PVM(2, C0, 4);  VRD(6);  if (GL) { KLOAD2(kn_, 0); } SBAR(); \
    PVM(3, C0, 6);  VRD(7);  SBAR(); \
    PVM(4, C0, 8);  VRD(8);  if (GL) { KLOAD2(kn_, 1); } SBAR(); \
    PVM(5, C0, 10); VRD(9);  SBAR(); \
    PVM(6, C0, 12); VRD(10); if (GL) { KLOAD2(kn_, 2); } SBAR(); \
    PVM(7, C0, 14); VRD(11); SBAR(); \
    PVM(8, C1, 0);  VRD(12); if (GL) { KLOAD2(kn_, 3); } SBAR(); \
    PVM(9, C1, 2);  VRD(13); SBAR(); \
    PVM(10, C1, 4); VRD(14); SBAR(); \
    PVM(11, C1, 6); VRD(15); SBAR(); \
    PVM(12, C1, 8);  SBAR(); \
    PVM(13, C1, 10); SBAR(); \
    PVM(14, C1, 12); SBAR(); \
    PVM(15, C1, 14); SBAR(); \
    } while (0)
#define RESC() do { if (resc) { LDS_WAIT(); _Pragma("unroll") for (int r = 0; r < 16; ++r) { const float fr_ = wsf[crow(r, hi)]; _Pragma("unroll") for (int d_ = 0; d_ < 4; ++d_) o[d_][r] *= fr_; } } } while (0)
#define ROT() do { k_cur = k_next; k_next = (k_next == 2) ? 0 : k_next + 1; v_prev = v_cur; v_cur = v_next; v_next = (v_next == 2) ? 0 : v_next + 1; } while (0)
    int k_cur = 1, k_next = 2, v_prev = 0, v_cur = 1, v_next = 2;
    int t = 1;
    for (; t + 4 < NT; t += 2) {
        STEP(pB0, pB1, pA0, pA1, t, true, true, true);     DA_WAIT_BAR(4); RESC(); ROT();
        STEP(pA0, pA1, pB0, pB1, t + 1, true, true, true); DA_WAIT_BAR(4); RESC(); ROT();
    }
    STEP(pB0, pB1, pA0, pA1, NT - 3, false, true, true);  DA_WAIT_BAR(2); RESC(); ROT();
    STEP(pA0, pA1, pB0, pB1, NT - 2, false, true, true);  DA_WAIT_BAR(0); RESC(); ROT();
    STEP(pB0, pB1, pA0, pA1, NT - 1, false, false, false); RESC();
    { float sacc = pB0[0] + pB0[1];
#pragma unroll
      for (int r = 2; r < 16; ++r) sacc += pB0[r];
#pragma unroll
      for (int r = 0; r < 16; ++r) sacc += pB1[r];
      l_reg += sacc;
      pw0 = (v4u){PKW(pB0, 0), PKW(pB0, 2), PKW(pB0, 4), PKW(pB0, 6)}; pw1 = (v4u){PKW(pB0, 8), PKW(pB0, 10), PKW(pB0, 12), PKW(pB0, 14)};
      pw2 = (v4u){PKW(pB1, 0), PKW(pB1, 2), PKW(pB1, 4), PKW(pB1, 6)}; pw3 = (v4u){PKW(pB1, 8), PKW(pB1, 10), PKW(pB1, 12), PKW(pB1, 14)};
      const LAS char* vp_ = vp0 + v_cur * DA_VS;
#pragma unroll
      for (int d0 = 0; d0 < 4; ++d0) {
          { const s16x4 lo = vtr(vp_ + d0 * 4096), hh = vtr(vp_ + d0 * 4096 + 512); o[d0] = __builtin_amdgcn_mfma_f32_32x32x16_bf16(PAF(0), ((bf16x8){lo[0], lo[1], lo[2], lo[3], hh[0], hh[1], hh[2], hh[3]}), o[d0], 0, 0, 0); }
          { const s16x4 lo = vtr(vp_ + d0 * 4096 + 1024), hh = vtr(vp_ + d0 * 4096 + 1024 + 512); o[d0] = __builtin_amdgcn_mfma_f32_32x32x16_bf16(PAF(1), ((bf16x8){lo[0], lo[1], lo[2], lo[3], hh[0], hh[1], hh[2], hh[3]}), o[d0], 0, 0, 0); }
          { const s16x4 lo = vtr(vp_ + d0 * 4096 + 2048), hh = vtr(vp_ + d0 * 4096 + 2048 + 512); o[d0] = __builtin_amdgcn_mfma_f32_32x32x16_bf16(PAF(2), ((bf16x8){lo[0], lo[1], lo[2], lo[3], hh[0], hh[1], hh[2], hh[3]}), o[d0], 0, 0, 0); }
          { const s16x4 lo = vtr(vp_ + d0 * 4096 + 3072), hh = vtr(vp_ + d0 * 4096 + 3072 + 512); o[d0] = __builtin_amdgcn_mfma_f32_32x32x16_bf16(PAF(3), ((bf16x8){lo[0], lo[1], lo[2], lo[3], hh[0], hh[1], hh[2], hh[3]}), o[d0], 0, 0, 0); }
      } }
#undef DMA_K
#undef DMA_V
#undef SGP
#undef TCLASS
#undef TBIAS
#undef SET_CINIT
#undef DIAG_BIAS
#undef KLOAD2
#undef PKW
#undef PAF
#undef VFR
#undef PIN
#undef EX
#undef VRD
#undef GAPA
#undef PVM
#undef STEP
#undef RESC
#undef ROT
    float lsum = l_reg;
    asm volatile("s_waitcnt lgkmcnt(0)\n\ts_barrier" ::: "memory");
    { auto rr = __builtin_amdgcn_permlane32_swap(__float_as_uint(lsum), __float_as_uint(lsum), false, false); lsum = __uint_as_float(rr[0]) + __uint_as_float(rr[1]); }
    if (hi == 0) wsf[32 + r32] = 1.0f / lsum;
    LDS_WAIT();
    LAS float* ex = (LAS float*)lds + wid * 4096;
#pragma unroll
    for (int r = 0; r < 16; ++r) { const int row = crow(r, hi); const float rl = wsf[32 + row];
#pragma unroll
        for (int d = 0; d < 4; ++d) ex[row * 128 + d * 32 + r32] = o[d][r] * rl; }
    asm volatile("s_waitcnt lgkmcnt(0)\n\ts_barrier" ::: "memory");
    {
        const float g0 = subln_g[2 * lane], g1 = subln_g[2 * lane + 1];
#pragma unroll 4
        for (int j = 0; j < 16; ++j) { const int qi = wid * 16 + j, w1 = qi >> 5, rr_ = qi & 31;
            const LAS float* e1 = (const LAS float*)lds + w1 * 4096 + rr_ * 128 + 2 * lane; const LAS float* e2 = e1 + 4 * 4096;
            const float d0v = e1[0] - lam * e2[0], d1v = e1[1] - lam * e2[1];
            const float ss = wave_sum(d0v * d0v + d1v * d1v);
            const float rs = __builtin_amdgcn_rsqf(ss * (1.0f / 128.0f) + DA_EPS) * out_scale;
            *(unsigned*)(OB + (rowbase + q0 + qi) * D + h * 128 + 2 * lane) = pk2(d0v * rs * g0, d1v * rs * g1); }
    }
    asm volatile("s_waitcnt lgkmcnt(0)\n\ts_barrier" ::: "memory");
}

__device__ __forceinline__ void na_unit(int b, int h, int g, const bf16* HB, bf16* OB, LAS unsigned char* lds, const float* rpb_lh  ) {
    const int tid = tid_opaque(), lane = tid & 63, r32 = lane & 31, hi = lane >> 5; const int wid = __builtin_amdgcn_readfirstlane(tid >> 6);
    const int gr = 4 * g + (wid >> 1), hq = wid & 1;
    const size_t rowbase = (size_t)b * SEQ;
    volatile LAS float* wsf = (volatile LAS float*)(lds + WSF_OFF) + wid * 64;
    LAS float* rp = (LAS float*)(lds + RPB_OFF);
    if (tid < 465) rp[tid] = rpb_lh[tid] * LOG2E;
    const int ulo = min(max(4 * g - 4, 0), GROWS - 8), uhi = min(max(4 * g - 1, 0), GROWS - 8) + 8, NT = uhi - ulo;
    const int rs = min(max(gr - 4, 0), GROWS - 8);
    const bf16* Qw = HB + (rowbase + (size_t)gr * 64 + hq * 32) * PW + 1536 + h * 64;
    const bf16* ksrc = HB + (rowbase + (size_t)ulo * 64 + lane) * PW + 2048 + h * 64 + wid * 8;
    const bf16* vsrc = HB + (rowbase + (size_t)ulo * 64 + 16 * (wid & 3) + (lane >> 2)) * PW + 2560 + h * 64 + 32 * (wid >> 2) + (lane & 3) * 8;
    LAS unsigned char* kdst = lds + wid * 1024; LAS unsigned char* vdst = lds + 8192 + wid * 1024;
#define NA_DMA(t, slot) do { const size_t to_ = (size_t)(t) * 64 * PW; glds16(ksrc + to_, kdst + (slot)); glds16(vsrc + to_, vdst + (slot)); } while (0)
    NA_DMA(0, 0);
    bf16x8 qr[4];
#pragma unroll
    for (int d0 = 0; d0 < 4; ++d0) qr[d0] = *(const bf16x8*)(Qw + (size_t)r32 * PW + d0 * 16 + hi * 8);
    float mhat = 0.f, lsum = 0.f; f32x16 o[2];
#pragma unroll
    for (int d = 0; d < 2; ++d)
#pragma unroll
        for (int r = 0; r < 16; ++r) o[d][r] = 0.f;
    const LAS char* kb0 = (const LAS char*)lds + hi * 1024 + r32 * 16;
    const LAS char* vb0 = (const LAS char*)lds + 8192 + ((lane >> 4) & 1) * 32 + (lane & 3) * 8 + (4 * hi + ((lane & 15) >> 2)) * 64;
    const int qc = hq * 32 + r32, cs = min(max(qc - 8, 0), GRIDW - 16);
    ATT_WAIT_BAR();
    bool first = true;
    for (int t = 0; t < NT; ++t) {
        const int cur = (t & 1) * 16384;
        if (t + 1 < NT) NA_DMA(t + 1, cur ^ 16384);
        const int u = ulo + t;
        if (u >= rs && u < rs + 8) {
            f32x16 p0, p1;
            qkt(p0, p1, kb0 + cur, qr, -mhat);
            const int ro = (u - gr + 7) * 31 + 15 - qc;
#pragma unroll
            for (int r = 0; r < 16; ++r) { const int kc0 = crow(r, hi), kc1 = kc0 + 32;
                const bool ok0 = (unsigned)(kc0 - cs) < 16u, ok1 = (unsigned)(kc1 - cs) < 16u;
                const float b0 = rp[ok0 ? ro + kc0 : 0], b1 = rp[ok1 ? ro + kc1 : 0];
                p0[r] = ok0 ? p0[r] + b0 : -INFINITY; p1[r] = ok1 ? p1[r] + b1 : -INFINITY; }
            softmax_pv<2>(p0, p1, mhat, lsum, o, first, wsf, vb0 + cur, r32, hi);
            first = false;
        }
        ATT_WAIT_BAR();
    }
#undef NA_DMA
    { auto rr = __builtin_amdgcn_permlane32_swap(__float_as_uint(lsum), __float_as_uint(lsum), false, false); lsum = __uint_as_float(rr[0]) + __uint_as_float(rr[1]); }
    if (hi == 0) wsf[32 + r32] = 1.0f / lsum;
    LDS_WAIT();
    LAS bf16* stg = (LAS bf16*)(lds + 65536) + wid * 2048;
#pragma unroll
    for (int r = 0; r < 16; ++r) { const int row = crow(r, hi); const float rl = wsf[32 + row];
#pragma unroll
        for (int d = 0; d < 2; ++d) stg[row * 64 + d * 32 + r32] = (bf16)(pk2(o[d][r] * rl, 0.f) & 0xffffu); }
    LDS_WAIT();
    bf16* Ow = OB + (rowbase + (size_t)gr * 64 + hq * 32) * D + 512 + h * 64;
#pragma unroll
    for (int i = 0; i < 4; ++i) { const int row = i * 8 + (lane >> 3), ch = lane & 7; const v4u v = *(const LAS v4u*)(stg + row * 64 + ch * 8); *(v4u*)(Ow + (size_t)row * D + ch * 8) = v; }
    asm volatile("s_waitcnt lgkmcnt(0)\n\ts_barrier" ::: "memory");
}

__device__ __forceinline__ int t5_bucket(int rel) {
    const int n = rel < 0 ? -rel : rel; int ret = rel > 0 ? 16 : 0;
    if (n < 8) return ret + n;
    const float v = logf((float)n / 8.0f) / 2.772588722239781f * 8.0f;
    int large = 8 + (int)v; large = large < 15 ? large : 15;
    return ret + large;
}
__device__ __forceinline__ void attn_phase(KP P, int l, LAS unsigned char* lds, int vcu, int G) {
    const int tid = tid_opaque(), lane = tid & 63;
    unsigned char* ws = P->ws;
    const bf16* HB = (const bf16*)(ws + WS_HB); bf16* OB = (bf16*)(ws + WS_OB);
    { LAS float* bt = (LAS float*)(lds + BTAB_OFF);
      for (int i = tid; i < 4 * 257; i += NWAVES * 64) { const int hh = i / 257, j = i % 257; bt[hh * 260 + j] = P->in[I_T5][t5_bucket(j - 128) * 4 + hh] * LOG2E; } }
    const float lam_init = 0.8f - 0.6f * expf(-0.3f * (float)l);
    const float d1 = wave_sum(P->in[I_LQ1][l * 64 + lane] * P->in[I_LK1][l * 64 + lane]);
    const float d2 = wave_sum(P->in[I_LQ2][l * 64 + lane] * P->in[I_LK2][l * 64 + lane]);
    const float lam = __int_as_float(__builtin_amdgcn_readfirstlane(__float_as_int(expf(d1) - expf(d2) + lam_init)));
    __syncthreads();
    for (int U = vcu; U < 16 * 64; U += G) { const int bh = U >> 6, qb = U & 63; da_unit(bh >> 2, bh & 3, qb, HB, OB, lds, lam, 1.0f - lam_init, P->in[I_SUBLN] + l * 128); }
    for (int U = vcu; U < 4 * 8 * 32; U += G) { const int bh = U >> 5, g = U & 31; na_unit(bh >> 3, bh & 7, g, HB, OB, lds, P->in[I_RPB] + ((size_t)l * 8 + (bh & 7)) * 465); }
}
}

__device__ __forceinline__ void ln_router_phase(KP P, int l, LAS unsigned char* lds, int G, int wave, int lane) {
    unsigned char* ws = P->ws;
    const float* PRE = (const float*)(ws + WS_PRE); float* X1F = (float*)(ws + WS_X1F); bf16* X1B = (bf16*)(ws + WS_X1B);
    int* TKE = (int*)(ws + WS_TKE); float* TKG = (float*)(ws + WS_TKG); int* SLOT = (int*)(ws + WS_SLOT); int* TOKL = (int*)(ws + WS_TOKL);
    const bf16* RWT = (const bf16*)(ws + WS_RWT) + (size_t)l * 32 * 1024;
    unsigned* cnt = (unsigned*)(ws + WS_CTL) + CW_CNT + 64 * l;
    f32x4 gv[4], bv[4];
#pragma unroll
    for (int j = 0; j < 4; ++j) { gv[j] = *(const f32x4*)(P->in[I_LN1G] + l * 1024 + 256 * j + 4 * lane); bv[j] = *(const f32x4*)(P->in[I_LN1B] + l * 1024 + 256 * j + 4 * lane); }
    const float rb0 = P->in[I_RB][l * 32 + (lane & 15)], rb1 = P->in[I_RB][l * 32 + 16 + (lane & 15)];
    LAS int* sel = (LAS int*)(lds + SEL_OFF);
    volatile LAS float* lgs = (volatile LAS float*)lds + wave * 512;
    for (int chunk = BLK(); chunk < T / 128; chunk += G) {
        const size_t row0 = (size_t)chunk * 128 + wave * 16;
        f32x4 nx[4];
#pragma unroll
        for (int j = 0; j < 4; ++j) nx[j] = *(const f32x4*)(PRE + row0 * D + 256 * j + 4 * lane);
        for (int rr = 0; rr < 16; ++rr) {
            const size_t row = row0 + rr;
            f32x4 v[4]; float s = 0.f;
#pragma unroll
            for (int j = 0; j < 4; ++j) { v[j] = nx[j]; s += (v[j][0] + v[j][1]) + (v[j][2] + v[j][3]); }
            if (rr + 1 < 16) {
#pragma unroll
                for (int j = 0; j < 4; ++j) nx[j] = *(const f32x4*)(PRE + (row + 1) * D + 256 * j + 4 * lane); }
            const float mean = wave_sum(s) * (1.f / D); float s2 = 0.f;
#pragma unroll
            for (int j = 0; j < 4; ++j) { v[j] = v[j] - mean; s2 += (v[j][0] * v[j][0] + v[j][1] * v[j][1]) + (v[j][2] * v[j][2] + v[j][3] * v[j][3]); }
            const float rstd = 1.f / sqrtf(wave_sum(s2) * (1.f / D) + LN_EPS);
#pragma unroll
            for (int j = 0; j < 4; ++j) { v[j] = v[j] * rstd * gv[j] + bv[j];
                *(f32x4*)(X1F + row * D + 256 * j + 4 * lane) = v[j];
                v2u o; o.x = pk2(v[j][0], v[j][1]); o.y = pk2(v[j][2], v[j][3]); *(v2u*)(X1B + row * D + 256 * j + 4 * lane) = o; }
        }
        __syncthreads();
        { pg8::f32x4 a0 = {0.f, 0.f, 0.f, 0.f}, a1 = {0.f, 0.f, 0.f, 0.f};
          const bf16* ap = X1B + (row0 + (lane & 15)) * D + 8 * (lane >> 4); const bf16* bp = RWT + (size_t)(lane & 15) * 1024 + 8 * (lane >> 4);
#pragma unroll 8
          for (int sidx = 0; sidx < 32; ++sidx) { const bf16x8 av = *(const bf16x8*)(ap + 32 * sidx), b0 = *(const bf16x8*)(bp + 32 * sidx), b1 = *(const bf16x8*)(bp + 16 * 1024 + 32 * sidx);
              a0 = __builtin_amdgcn_mfma_f32_16x16x32_bf16(av, b0, a0, 0, 0, 0); a1 = __builtin_amdgcn_mfma_f32_16x16x32_bf16(av, b1, a1, 0, 0, 0); }
#pragma unroll
          for (int r = 0; r < 4; ++r) { lgs[(4 * (lane >> 4) + r) * 32 + (lane & 15)] = a0[r] + rb0; lgs[(4 * (lane >> 4) + r) * 32 + 16 + (lane & 15)] = a1[r] + rb1; } }
        LDS_WAIT();
        if (lane < 16) { const size_t row = row0 + lane; const int rloc = wave * 16 + lane;
            int s0 = -1, s1 = -1, s2 = -1, s3 = -1; float v0 = 0.f, v1 = 0.f, v2 = 0.f, v3 = 0.f;
#pragma unroll 1
            for (int k = 0; k < 4; ++k) { float best = -INFINITY; int bi = 0;
#pragma unroll 4
                for (int e = 0; e < 32; ++e) { const float x = lgs[lane * 32 + e]; const bool ok = (e != s0) && (e != s1) && (e != s2) && (x > best); best = ok ? x : best; bi = ok ? e : bi; }
                if (k == 0) { s0 = bi; v0 = best; } else if (k == 1) { s1 = bi; v1 = best; } else if (k == 2) { s2 = bi; v2 = best; } else { s3 = bi; v3 = best; } }
            const float e1 = expf(v1 - v0), e2 = expf(v2 - v0), e3 = expf(v3 - v0); const float inv = 1.0f / (1.0f + e1 + e2 + e3);
            *(f32x4*)(TKG + row * 4) = (f32x4){inv, e1 * inv, e2 * inv, e3 * inv};
            *(v4u*)(TKE + row * 4) = (v4u){(unsigned)s0, (unsigned)s1, (unsigned)s2, (unsigned)s3};
            sel[rloc * 4 + 0] = s0; sel[rloc * 4 + 1] = s1; sel[rloc * 4 + 2] = s2; sel[rloc * 4 + 3] = s3; }
        __syncthreads();
        for (int ee = 0; ee < 4; ++ee) { const int e = wave * 4 + ee; int total = 0;
            for (int ch = 0; ch < 8; ++ch) { const unsigned long long m = __ballot(sel[ch * 64 + lane] == e); total += __popcll(m); }
            unsigned base = 0; if (lane == 0 && total > 0) base = xb_add(cnt + e, (unsigned)total);
            base = (unsigned)__builtin_amdgcn_readfirstlane((int)base);
            int run = 0;
            for (int ch = 0; ch < 8; ++ch) { const bool mt = sel[ch * 64 + lane] == e; const unsigned long long m = __ballot(mt);
                if (mt) { const int pos = (int)base + run + __popcll(m & ((1ull << lane) - 1ull)); const int id = chunk * 512 + ch * 64 + lane; TOKL[(size_t)e * T + pos] = id; SLOT[id] = pos; }
                run += __popcll(m); } }
        __syncthreads();
    }
}

__device__ __forceinline__ void sort_phase(KP P, int l, LAS unsigned char* lds, int vcu, int G, int wave, int lane) {
    unsigned char* ws = P->ws;
    LAS int* poff = (LAS int*)(lds + POFF_OFF); LAS unsigned char* te = lds + TILEE_OFF;
    unsigned* cnt = (unsigned*)(ws + WS_CTL) + CW_CNT + 64 * l;
    LAS int* ecnt = (LAS int*)(lds + ECNT_OFF);
    if (threadIdx.x == 0) { int off = 0;
        _Pragma("nounroll") for (int e = 0; e < NE; ++e) { poff[e] = off; int c = (int)xb_ld(cnt + e); c = c > T ? T : c; ecnt[e] = c; const int nt = (c + 255) >> 8; _Pragma("nounroll") for (int i = 0; i < nt; ++i) ((volatile LAS unsigned char*)te)[(off >> 8) + i] = (unsigned char)e; off += nt << 8; }
        poff[NE] = off; }
    __syncthreads();
    const int* TOKL = (const int*)(ws + WS_TOKL); const bf16* X1B = (const bf16*)(ws + WS_X1B); bf16* XS = (bf16*)(ws + WS_XS);
    const int MP = poff[NE];
    for (int s = vcu * NWAVES + wave; s < MP; s += G * NWAVES) {
        const int e = (int)te[s >> 8]; const int i = s - poff[e]; const int c = ecnt[e];
        v4u a = (v4u){0u, 0u, 0u, 0u}, b2 = a;
        if (i < c) { const int id = TOKL[(size_t)e * T + i]; const v4u* src = (const v4u*)(X1B + (size_t)(id >> 2) * D); a = src[lane]; b2 = src[64 + lane]; }
        v4u* dst = (v4u*)(XS + (size_t)s * D); dst[lane] = a; dst[64 + lane] = b2;
    }
}

__device__ __forceinline__ void combine_phase(KP P, int l, LAS unsigned char* lds, int vcu, int G, int wave, int lane) {
    unsigned char* ws = P->ws;
    const LAS int* poff = (const LAS int*)(lds + POFF_OFF);
    const float* X1F = (const float*)(ws + WS_X1F); const bf16* Y = (const bf16*)(ws + WS_Y);
    const int* TKE = (const int*)(ws + WS_TKE); const float* TKG = (const float*)(ws + WS_TKG); const int* SLOT = (const int*)(ws + WS_SLOT);
    float* OUT = (l == DEPTH - 1) ? P->out : (float*)(ws + WS_X2F); bf16* XB = (bf16*)(ws + WS_XB);
    f32x4 gv[4], bv[4];
#pragma unroll
    for (int j = 0; j < 4; ++j) { gv[j] = *(const f32x4*)(P->in[I_LN2G] + l * 1024 + 256 * j + 4 * lane); bv[j] = *(const f32x4*)(P->in[I_LN2B] + l * 1024 + 256 * j + 4 * lane); }
    for (int row = vcu * NWAVES + wave; row < T; row += G * NWAVES) {
        const v4u ei = *(const v4u*)(TKE + (size_t)row * 4), sl = *(const v4u*)(SLOT + (size_t)row * 4); const f32x4 gt = *(const f32x4*)(TKG + (size_t)row * 4);
        f32x4 v[4];
#pragma unroll
        for (int j = 0; j < 4; ++j) v[j] = *(const f32x4*)(X1F + (size_t)row * D + 256 * j + 4 * lane) * DN_ALPHA;
#pragma unroll
        for (int k = 0; k < 4; ++k) { const int e = (int)ei[k] & 31; const size_t srow = (size_t)(poff[e] + (int)sl[k]); const float gk = gt[k];
#pragma unroll
            for (int j = 0; j < 4; ++j) { const v2u y = *(const v2u*)(Y + srow * D + 256 * j + 4 * lane);
                v[j][0] += gk * bf_lo(y.x); v[j][1] += gk * bf_hi(y.x); v[j][2] += gk * bf_lo(y.y); v[j][3] += gk * bf_hi(y.y); } }
        float s = 0.f;
#pragma unroll
        for (int j = 0; j < 4; ++j) s += (v[j][0] + v[j][1]) + (v[j][2] + v[j][3]);
        const float mean = wave_sum(s) * (1.f / D); float s2 = 0.f;
#pragma unroll
        for (int j = 0; j < 4; ++j) { v[j] = v[j] - mean; s2 += (v[j][0] * v[j][0] + v[j][1] * v[j][1]) + (v[j][2] * v[j][2] + v[j][3] * v[j][3]); }
        const float rstd = 1.f / sqrtf(wave_sum(s2) * (1.f / D) + LN_EPS);
#pragma unroll
        for (int j = 0; j < 4; ++j) { v[j] = v[j] * rstd * gv[j] + bv[j];
            *(f32x4*)(OUT + (size_t)row * D + 256 * j + 4 * lane) = v[j];
            v2u o; o.x = pk2(v[j][0], v[j][1]); o.y = pk2(v[j][2], v[j][3]); *(v2u*)(XB + (size_t)row * D + 256 * j + 4 * lane) = o; }
    }
}

#define KPARAMS() ({ KP q_ = (KP)__builtin_amdgcn_kernarg_segment_ptr(); asm volatile("" : "+s"(q_)); q_; })

__device__ __forceinline__ void seam(KP P, LAS unsigned char* lds, int k) {
    if (MK_N_LAUNCHES != 1) return;
    if (!(P->ph_lo <= k && k + 1 < P->ph_hi)) return;
    XcdBarrier b; b.bar = (unsigned*)(P->ws + WS_CTL) + CW_BAR; b.x = xb_xcc_id(); b.st = (volatile LAS unsigned*)(lds + MISC_OFF) + 8;
    xcd_barrier(b);
}
__device__ __forceinline__ void build_offsets(KP P, int l, LAS unsigned char* lds) {
    LAS int* poff = (LAS int*)(lds + POFF_OFF); LAS unsigned char* te = lds + TILEE_OFF; LAS int* ecnt = (LAS int*)(lds + ECNT_OFF);
    unsigned* cnt = (unsigned*)(P->ws + WS_CTL) + CW_CNT + 64 * l;
    if (threadIdx.x == 0) { int off = 0;
        _Pragma("nounroll") for (int e = 0; e < NE; ++e) { poff[e] = off; int c = (int)xb_ld(cnt + e); c = c > T ? T : c; ecnt[e] = c; const int nt = (c + 255) >> 8; _Pragma("nounroll") for (int i = 0; i < nt; ++i) ((volatile LAS unsigned char*)te)[(off >> 8) + i] = (unsigned char)e; off += nt << 8; }
        poff[NE] = off; }
    __syncthreads();
}
template <int l> __device__ __forceinline__ void layer_phases(LAS unsigned char* lds0_) {
#define LDSP() ({ LAS unsigned char* p_ = lds0_; asm volatile("" : "+s"(p_)); p_; })
#define IN(k) (P->ph_lo <= (k) && (k) < P->ph_hi)
#define LANE() (tid_opaque() & 63)
#define WAVE() (__builtin_amdgcn_readfirstlane(tid_opaque() >> 6))

        const int pb = 1 + 8 * l;
        { KP P = KPARAMS(); LAS unsigned char* lds = LDSP(); if (IN(pb + 0)) { unsigned char* ws = P->ws;
            pg8::Gemm g{(const pg8::bf16_t*)(ws + WS_XB), (const pg8::bf16_t*)(ws + WS_WIN) + (size_t)l * PW * D, T, PW, D};
            pg8::TileOrder S; S.init(T / 256, PW / 256, GRD(), BLK(), nullptr, 0);
            pg8::EpiInProj E{(pg8::bf16_t*)(ws + WS_HB), PW, C2};
            pg8::gemm_phase<pg8::EpiInProj, pg8::TileOrder, PG8_ALIGN, PG8_SP2>(lds + RING_OFF, g, S, E);
            seam(KPARAMS(), lds, pb + 0); } }
        { KP P = KPARAMS(); LAS unsigned char* lds = LDSP(); if (IN(pb + 1)) { att::attn_phase(P, l, lds, VCU(), GRD()); seam(KPARAMS(), lds, pb + 1); } }
        { KP P = KPARAMS(); LAS unsigned char* lds = LDSP(); if (IN(pb + 2)) { unsigned char* ws = P->ws;
            pg8::Gemm g{(const pg8::bf16_t*)(ws + WS_OB), (const pg8::bf16_t*)(ws + WS_WOUT) + (size_t)l * D * D, T, D, D};
            pg8::TileOrder S; S.init(T / 256, D / 256, GRD(), BLK(), nullptr, 0);
            pg8::EpiResF32 E{(float*)(ws + WS_PRE), (l == 0) ? P->in[I_X] : (const float*)(ws + WS_X2F), D, DN_ALPHA};
            pg8::gemm_phase<pg8::EpiResF32, pg8::TileOrder, PG8_ALIGN, PG8_SP2>(lds + RING_OFF, g, S, E);
            seam(KPARAMS(), lds, pb + 2); } }
        { KP P = KPARAMS(); LAS unsigned char* lds = LDSP(); if (IN(pb + 3)) { ln_router_phase(P, l, lds, GRD(), WAVE(), LANE()); seam(KPARAMS(), lds, pb + 3); } }
        { KP P = KPARAMS(); LAS unsigned char* lds = LDSP(); if (IN(pb + 4) || (P->ph_hi > pb + 4 && P->ph_lo <= pb + 7 && P->ph_lo > pb + 4)) build_offsets(P, l, lds); }
        { KP P = KPARAMS(); LAS unsigned char* lds = LDSP(); if (IN(pb + 5)) { unsigned char* ws = P->ws;
            const int MP = ((const LAS int*)(lds + POFF_OFF))[NE];
            pg8::Gemm g{(const pg8::bf16_t*)(ws + WS_X1B), (const pg8::bf16_t*)(ws + WS_WGU) + (size_t)l * NE * 2048 * 1024, MP, 2048, D};
            pg8::TileOrder S; S.init(MP / 256, 8, GRD(), BLK(), lds + TILEE_OFF, (size_t)2048 * 1024 * 2); S.rt = (const LAS unsigned short*)(lds + ROWT_OFF);
            { const int tid = tid_opaque(); const LAS int* poff = (const LAS int*)(lds + POFF_OFF); const LAS int* ecnt = (const LAS int*)(lds + ECNT_OFF); const int* TOKL = (const int*)(ws + WS_TOKL);
              LAS unsigned short* rt = (LAS unsigned short*)(lds + ROWT_OFF); pg8::Unit u;
              for (int i = tid >> 8; i < ROWT_UNITS && S.next(i, u); i += 2) { const int r = tid & 255, e = u.e, idx = 256 * u.pm + r - poff[e];
                  int tok = 0; if (idx < ecnt[e]) tok = TOKL[(size_t)e * T + idx] >> 2; rt[i * 256 + r] = (unsigned short)tok; }
              __syncthreads(); }
            pg8::EpiSwiGLU E{(pg8::bf16_t*)(ws + WS_HID), P->in[I_BGU] + (size_t)l * NE * 2048};
            pg8::gemm_phase<pg8::EpiSwiGLU, pg8::TileOrder, PG8_ALIGN, PG8_SP2, true>(lds + RING_OFF, g, S, E);
            seam(KPARAMS(), lds, pb + 5); } }
        { KP P = KPARAMS(); LAS unsigned char* lds = LDSP(); if (IN(pb + 6)) { unsigned char* ws = P->ws;
            const int MP = ((const LAS int*)(lds + POFF_OFF))[NE];
            pg8::Gemm g{(const pg8::bf16_t*)(ws + WS_HID), (const pg8::bf16_t*)(ws + WS_WDN) + (size_t)l * NE * 1024 * 1024, MP, 1024, DFF};
            pg8::TileOrder S; S.init(MP / 256, 4, GRD(), BLK(), lds + TILEE_OFF, (size_t)1024 * 1024 * 2);
            pg8::EpiDown E{(pg8::bf16_t*)(ws + WS_Y), P->in[I_BDN] + (size_t)l * NE * 1024};
            pg8::gemm_phase<pg8::EpiDown, pg8::TileOrder, PG8_ALIGN, PG8_SP2>(lds + RING_OFF, g, S, E);
            seam(KPARAMS(), lds, pb + 6); } }
        { KP P = KPARAMS(); LAS unsigned char* lds = LDSP(); if (IN(pb + 7)) { combine_phase(P, l, lds, VCU(), GRD(), WAVE(), LANE()); seam(KPARAMS(), lds, pb + 7); } }

#undef IN
#undef LANE
#undef WAVE
#undef LDSP
}
__global__ void __launch_bounds__(NWAVES * 64, 2) mk_fwd(Params Pv) {
    extern __shared__ __attribute__((aligned(16))) unsigned char lds_raw[];
    LAS unsigned char* lds0_ = (LAS unsigned char*)lds_raw;
#define LDSP() ({ LAS unsigned char* p_ = lds0_; asm volatile("" : "+s"(p_)); p_; })
    LAS unsigned char* lds = LDSP();
    for (int u = threadIdx.x; u < (LDS_BYTES - LDSCTL_OFF) / 4; u += NWAVES * 64) ((LAS unsigned*)(lds + LDSCTL_OFF))[u] = 0u;
    __syncthreads();
    if (MK_N_LAUNCHES == 1) { KP P = KPARAMS(); (void)xcd_barrier_post((unsigned*)(P->ws + WS_CTL) + CW_BAR, (volatile LAS unsigned*)(lds + MISC_OFF) + 8); }
#define IN(k) (P->ph_lo <= (k) && (k) < P->ph_hi)
#define LANE() (tid_opaque() & 63)
#define WAVE() (__builtin_amdgcn_readfirstlane(tid_opaque() >> 6))

    { KP P = KPARAMS(); if (IN(0)) { p0_prologue(P, lds, VCU(), GRD(), WAVE(), LANE()); __syncthreads(); seam(KPARAMS(), lds, 0); } }

    layer_phases<0>(lds0_);
    layer_phases<1>(lds0_);
#undef IN
}

extern "C" void kernel_launch(void* const* d_in, const int* in_sizes, int n_in, void* d_out, int out_size, void* d_ws, size_t ws_size, hipStream_t stream) {
    static int grid = 0;
    if (grid == 0) {
        if (n_in != 20 || in_sizes[0] != T * D || out_size != T * D || ws_size < WS_END) { fprintf(stderr, "kernel_launch: unexpected shapes (n_in %d, in0 %d, out %d, ws %zu)\n", n_in, n_in > 0 ? in_sizes[0] : -1, out_size, ws_size); grid = -1; return; }
        int dev = 0, cus = 0, per_cu = 0;
        if (hipGetDevice(&dev) != hipSuccess || hipDeviceGetAttribute(&cus, hipDeviceAttributeMultiprocessorCount, dev) != hipSuccess) { grid = -1; return; }
        if (hipFuncSetAttribute((const void*)mk_fwd, hipFuncAttributeMaxDynamicSharedMemorySize, LDS_BYTES) != hipSuccess) { fprintf(stderr, "kernel_launch: hipFuncSetAttribute failed\n"); grid = -1; return; }
        if (hipOccupancyMaxActiveBlocksPerMultiprocessor(&per_cu, (const void*)mk_fwd, NWAVES * 64, LDS_BYTES) != hipSuccess || per_cu < 1) fprintf(stderr, "kernel_launch: occupancy query reports %d\n", per_cu);
        (void)hipGetLastError();
        grid = cus;
    }
    if (grid < 0) return;
    if (hipMemsetAsync((char*)d_ws + WS_CTL, 0, CTL_ZERO_BYTES, stream) != hipSuccess) return;
    Params p{};
    for (int i = 0; i < 20; ++i) p.in[i] = (const float*)d_in[i];
    p.out = (float*)d_out; p.ws = (unsigned char*)d_ws;
    if (MK_N_LAUNCHES == 1) { p.ph_lo = 0; p.ph_hi = N_PHASES; hipLaunchKernelGGL(mk_fwd, dim3(grid), dim3(NWAVES * 64), LDS_BYTES, stream, p); }
    else { for (int k = 0; k < N_PHASES; ++k) { p.ph_lo = k; p.ph_hi = k + 1; hipLaunchKernelGGL(mk_fwd, dim3(grid), dim3(NWAVES * 64), LDS_BYTES, stream, p); } }
}
```
